# Optimizing an MI355X kernel written in HIP

```python
import math
import jax, jax.numpy as jnp
from jax import lax
import numpy as np

D_MODEL = 1024
BATCH = 8
SEQ = 2048
DEPTH = 1

CHUNK = 64
MEM_LEN = 256
EPS = 1e-6
S5_WIDTH = D_MODEL // 2
S5_GROUP_DIM = 16
S5_GROUPS = S5_WIDTH // S5_GROUP_DIM
S5_STATE = 64
SGU_WIDTH = D_MODEL // 2
SGU_GROUPS = 4
SGU_GROUP_DIM = SGU_WIDTH // SGU_GROUPS
SGU_BLOCK = 2 * CHUNK
XA_HEADS = 4
XA_HEAD_DIM = 128
XA_WIDTH = XA_HEADS * XA_HEAD_DIM
N_BRANCHES = 3
D_FF = -(-8 * D_MODEL // (3 * 256)) * 256
SPLITS = (S5_WIDTH, S5_WIDTH + SGU_WIDTH, S5_WIDTH + 2 * SGU_WIDTH,
          S5_WIDTH + 2 * SGU_WIDTH + XA_WIDTH)
IN_WIDTH = S5_WIDTH + 2 * SGU_WIDTH + XA_WIDTH + N_BRANCHES * D_MODEL

kernel_name = "hybrid_s5_gmlp_memxattn_block"


def _rms(x, g):
    xf = x.astype(jnp.float32)
    y = xf * lax.rsqrt(jnp.mean(xf * xf, axis=-1, keepdims=True) + EPS)
    return (y * g.astype(jnp.float32)).astype(x.dtype)


def _layernorm(x, g, b):
    xf = x.astype(jnp.float32)
    mu = jnp.mean(xf, axis=-1, keepdims=True)
    var = jnp.mean(jnp.square(xf - mu), axis=-1, keepdims=True)
    y = (xf - mu) * lax.rsqrt(var + EPS)
    return (y * g.astype(jnp.float32) + b.astype(jnp.float32)).astype(x.dtype)


def _s5_combine(e1, e2):
    a1r, a1i, b1r, b1i = e1
    a2r, a2i, b2r, b2i = e2
    ar = a1r * a2r - a1i * a2i
    ai = a1r * a2i + a1i * a2r
    br = a2r * b1r - a2i * b1i + b2r
    bi = a2r * b1i + a2i * b1r + b2i
    return ar, ai, br, bi


def _s5(u, a_re, a_im, log_dt, bm_re, bm_im, cm_re, cm_im, d_skip):
    bsz, seq, _ = u.shape
    uf = u.astype(jnp.float32)
    ug = uf.reshape(bsz, seq, S5_GROUPS, S5_GROUP_DIM)
    ar = a_re.astype(jnp.float32)
    ai = a_im.astype(jnp.float32)
    dt = jnp.exp(log_dt.astype(jnp.float32))[:, None]
    mag = jnp.exp(ar * dt)
    ab_re = mag * jnp.cos(ai * dt)
    ab_im = mag * jnp.sin(ai * dt)
    nr = ab_re - 1.0
    den = ar * ar + ai * ai
    f_re = (nr * ar + ab_im * ai) / den
    f_im = (ab_im * ar - nr * ai) / den
    br = bm_re.astype(jnp.float32)
    bi = bm_im.astype(jnp.float32)
    bb_re = f_re[..., None] * br - f_im[..., None] * bi
    bb_im = f_re[..., None] * bi + f_im[..., None] * br
    bu_re = jnp.einsum('blgh,gph->blgp', ug, bb_re)
    bu_im = jnp.einsum('blgh,gph->blgp', ug, bb_im)
    a_re_seq = jnp.broadcast_to(ab_re, (1, seq, S5_GROUPS, S5_STATE))
    a_im_seq = jnp.broadcast_to(ab_im, (1, seq, S5_GROUPS, S5_STATE))
    _, _, s_re, s_im = lax.associative_scan(
        _s5_combine, (a_re_seq, a_im_seq, bu_re, bu_im), axis=1)
    y = (jnp.einsum('blgp,ghp->blgh', s_re, cm_re.astype(jnp.float32))
         - jnp.einsum('blgp,ghp->blgh', s_im, cm_im.astype(jnp.float32)))
    y = y.reshape(bsz, seq, S5_WIDTH) + d_skip.astype(jnp.float32) * uf
    return y.astype(u.dtype)


def _sgu(zu, zv, g_sgu, beta_sgu, w_s, b_s):
    bsz, seq, _ = zu.shape
    u = jax.nn.gelu(zu)
    v = _layernorm(jax.nn.gelu(zv), g_sgu, beta_sgu)
    v = v.reshape(bsz, seq // SGU_BLOCK, SGU_BLOCK, SGU_GROUPS, SGU_GROUP_DIM)
    mask = jnp.tril(jnp.ones((SGU_BLOCK, SGU_BLOCK), dtype=w_s.dtype))
    w = w_s * mask[None]
    sv = jnp.einsum('gts,bcsgd->bctgd', w, v) + b_s.T[None, None, :, :, None]
    return u * sv.reshape(bsz, seq, SGU_WIDTH)


def _mem_xattn(zq, mem, g_mem, w_kv):
    bsz, seq, _ = zq.shape
    q = zq.reshape(bsz, seq, XA_HEADS, XA_HEAD_DIM)
    kv = _rms(mem, g_mem) @ w_kv
    k, v = jnp.split(kv, 2, axis=-1)
    k = k.reshape(bsz, MEM_LEN, XA_HEADS, XA_HEAD_DIM)
    v = v.reshape(bsz, MEM_LEN, XA_HEADS, XA_HEAD_DIM)
    s = jnp.einsum('blhd,bmhd->bhlm', q, k).astype(jnp.float32) * (XA_HEAD_DIM ** -0.5)
    p = jax.nn.softmax(s, axis=-1).astype(v.dtype)
    o = jnp.einsum('bhlm,bmhd->blhd', p, v)
    return o.reshape(bsz, seq, XA_WIDTH)


def setup_inputs(seed: int = 0) -> dict:
    key = jax.random.key(seed)
    ks = jax.random.split(key, 32)

    def nrm(k, shape, scale):
        return jax.random.normal(k, shape, jnp.float32) * scale

    def gain(k, shape):
        return 1.0 + 0.05 * jax.random.normal(k, shape, jnp.float32)

    L = DEPTH
    G, P, H = S5_GROUPS, S5_STATE, S5_GROUP_DIM
    a_re = -0.5 * jnp.exp(0.1 * jax.random.normal(ks[5], (L, G, P), jnp.float32))
    a_im = (math.pi * jnp.arange(P, dtype=jnp.float32))[None, None, :] + \
        0.1 * jax.random.normal(ks[6], (L, G, P), jnp.float32)
    log_dt = jax.random.uniform(ks[7], (L, G), jnp.float32,
                                minval=math.log(1e-3), maxval=math.log(1e-1))
    return {
        "x": jax.random.normal(ks[0], (BATCH, SEQ, D_MODEL), jnp.float32),
        "mem": jax.random.normal(ks[1], (BATCH, MEM_LEN, D_MODEL), jnp.float32),
        "g_mix": gain(ks[2], (L, D_MODEL)),
        "w_in": nrm(ks[3], (L, D_MODEL, IN_WIDTH), D_MODEL ** -0.5),
        "b_gate": nrm(ks[4], (L, N_BRANCHES * D_MODEL), 0.02),
        "a_re": a_re,
        "a_im": a_im,
        "log_dt": log_dt,
        "bm_re": nrm(ks[8], (L, G, P, H), (2 * H) ** -0.5),
        "bm_im": nrm(ks[9], (L, G, P, H), (2 * H) ** -0.5),
        "cm_re": nrm(ks[10], (L, G, H, P), (2 * P) ** -0.5),
        "cm_im": nrm(ks[11], (L, G, H, P), (2 * P) ** -0.5),
        "d_skip": nrm(ks[12], (L, S5_WIDTH), 1.0),
        "w_glu": nrm(ks[13], (L, S5_WIDTH, S5_WIDTH), S5_WIDTH ** -0.5),
        "b_glu": nrm(ks[14], (L, S5_WIDTH), 0.02),
        "g_sgu": gain(ks[15], (L, SGU_WIDTH)),
        "beta_sgu": nrm(ks[16], (L, SGU_WIDTH), 0.02),
        "w_s": nrm(ks[17], (L, SGU_GROUPS, SGU_BLOCK, SGU_BLOCK), SGU_BLOCK ** -0.5),
        "b_s": gain(ks[18], (L, SGU_GROUPS, SGU_BLOCK)),
        "g_mem": gain(ks[19], (L, D_MODEL)),
        "w_kv": nrm(ks[20], (L, D_MODEL, 2 * XA_WIDTH), D_MODEL ** -0.5),
        "w_a_out": nrm(ks[21], (L, S5_WIDTH, D_MODEL), S5_WIDTH ** -0.5),
        "w_b_out": nrm(ks[22], (L, SGU_WIDTH, D_MODEL), SGU_WIDTH ** -0.5),
        "w_c_out": nrm(ks[23], (L, XA_WIDTH, D_MODEL), XA_WIDTH ** -0.5),
        "w_out": nrm(ks[24], (L, D_MODEL, D_MODEL), D_MODEL ** -0.5),
        "g_ffn": gain(ks[25], (L, D_MODEL)),
        "w_gate": nrm(ks[26], (L, D_MODEL, D_FF), D_MODEL ** -0.5),
        "w_up": nrm(ks[27], (L, D_MODEL, D_FF), D_MODEL ** -0.5),
        "w_down": nrm(ks[28], (L, D_FF, D_MODEL), D_FF ** -0.5),
        "g_final": gain(ks[29], (D_MODEL,)),
    }


def reference(x, mem, g_mix, w_in, b_gate, a_re, a_im, log_dt, bm_re, bm_im, cm_re, cm_im,
              d_skip, w_glu, b_glu, g_sgu, beta_sgu, w_s, b_s, g_mem, w_kv,
              w_a_out, w_b_out, w_c_out, w_out, g_ffn, w_gate, w_up, w_down, g_final):
    bsz, seq, _ = x.shape
    for l in range(DEPTH):
        h = _rms(x, g_mix[l])
        z = h @ w_in[l]
        za, zu, zv, zq, zg = jnp.split(z, SPLITS, axis=-1)
        ya = jax.nn.gelu(_s5(za, a_re[l], a_im[l], log_dt[l], bm_re[l], bm_im[l],
                             cm_re[l], cm_im[l], d_skip[l]))
        ya = (ya * jax.nn.sigmoid(ya @ w_glu[l] + b_glu[l])) @ w_a_out[l]
        yb = _sgu(zu, zv, g_sgu[l], beta_sgu[l], w_s[l], b_s[l]) @ w_b_out[l]
        yc = _mem_xattn(zq, mem, g_mem[l], w_kv[l]) @ w_c_out[l]
        gates = jax.nn.sigmoid(zg + b_gate[l]).reshape(bsz, seq, N_BRANCHES, D_MODEL)
        merged = gates[:, :, 0] * ya + gates[:, :, 1] * yb + gates[:, :, 2] * yc
        x = x + merged @ w_out[l]
        hf = _rms(x, g_ffn[l])
        x = x + (jax.nn.silu(hf @ w_gate[l]) * (hf @ w_up[l])) @ w_down[l]
    return _rms(x, g_final)
```

```cpp
#include <hip/hip_runtime.h>
#include <cstdio>
#include <cstdint>

typedef unsigned short bf16_t;
constexpr int NB = 8, SEQ = 2048, D = 1024, T = NB * SEQ, MEML = 256, TM = NB * MEML;
constexpr int S5W = 512, S5G = 32, S5H = 16, S5P = 64, LC = 16, NCH = T / LC, KE = LC * S5H + 2 * S5P;
constexpr int SGW = 512, SGG = 4, SGD = 128, SGB = 128;
constexpr int XH = 4, XD = 128, XW = 512;
constexpr int DFF = 2816, INW = 5120, NGU = 2 * DFF;
constexpr float EPS = 1e-6f;
constexpr size_t MiB = 1u << 20;
constexpr size_t WS_CTL = 0;
constexpr size_t CTL_SS1 = 256 * 1024, CTL_SS2 = 384 * 1024;
constexpr size_t WS_WIN = 1 * MiB, WS_WGU = 11 * MiB, WS_WD = 22 * MiB, WS_WKV = 28 * MiB, WS_WOUT = 30 * MiB;
constexpr size_t WS_WA = 32 * MiB, WS_WB = 33 * MiB, WS_WC = 34 * MiB, WS_WGLU = 35 * MiB, WS_KMAT = 36 * MiB, WS_WEND = 42 * MiB;
constexpr size_t WS_WM = 44 * MiB, WS_TABE = 44 * MiB + 256 * 1024, WS_TABB = 44 * MiB + 512 * 1024, WS_SGST = 45 * MiB;
constexpr size_t WS_MEMN = 46 * MiB, WS_KB = 50 * MiB, WS_VT = 52 * MiB;
constexpr size_t WS_R1 = 56 * MiB;
constexpr size_t WS_R2 = 88 * MiB;
constexpr size_t WS_R6 = 112 * MiB;
constexpr size_t WS_R7 = 128 * MiB;
constexpr size_t WS_END = 224 * MiB;

__device__ __forceinline__ float bf2f(bf16_t v) { return __uint_as_float((unsigned)v << 16); }
__device__ __forceinline__ bf16_t f2bf(float f) { unsigned u = __float_as_uint(f); return (bf16_t)((u + 0x7fffu + ((u >> 16) & 1u)) >> 16); }
__device__ __forceinline__ float gelu_t(float x) { const float u = 0.7978845608028654f * (x + 0.044715f * x * x * x); return 0.5f * x * (1.f + tanhf(u)); }
__device__ __forceinline__ float sigm(float x) { return 1.f / (1.f + expf(-x)); }
__device__ __forceinline__ float wave_sum(float v) {
#pragma unroll
    for (int o = 1; o < 64; o <<= 1) v += __shfl_xor(v, o);
    return v;
}
__device__ __forceinline__ float wave_max(float v) {
#pragma unroll
    for (int o = 1; o < 64; o <<= 1) v = fmaxf(v, __shfl_xor(v, o));
    return v;
}
__device__ __forceinline__ float dot8(uint4 a, uint4 b) {
    float s = 0.f;
    s += __uint_as_float(a.x << 16) * __uint_as_float(b.x << 16) + __uint_as_float(a.x & 0xffff0000u) * __uint_as_float(b.x & 0xffff0000u);
    s += __uint_as_float(a.y << 16) * __uint_as_float(b.y << 16) + __uint_as_float(a.y & 0xffff0000u) * __uint_as_float(b.y & 0xffff0000u);
    s += __uint_as_float(a.z << 16) * __uint_as_float(b.z << 16) + __uint_as_float(a.z & 0xffff0000u) * __uint_as_float(b.z & 0xffff0000u);
    s += __uint_as_float(a.w << 16) * __uint_as_float(b.w << 16) + __uint_as_float(a.w & 0xffff0000u) * __uint_as_float(b.w & 0xffff0000u);
    return s;
}
__device__ __forceinline__ float dotrow(const bf16_t* a, const bf16_t* b, int K) {
    float acc = 0.f;
    for (int k = 0; k < K; k += 8) acc += dot8(*(const uint4*)(a + k), *(const uint4*)(b + k));
    return acc;
}

__global__ void __launch_bounds__(512) k_tconv(const float* __restrict__ W, int K, int N, bf16_t* __restrict__ WT, int ldt, const float* __restrict__ scale, int mode, int row_off) {
    __shared__ float tile[64][65];
    const int n0 = blockIdx.x * 64, k0 = blockIdx.y * 64, tid = threadIdx.x;
#pragma unroll
    for (int i = 0; i < 8; ++i) { const int kk = i * 8 + (tid >> 6), nn = tid & 63; float v = W[(size_t)(k0 + kk) * N + n0 + nn]; if (scale) v *= scale[k0 + kk]; tile[kk][nn] = v; }
    __syncthreads();
    const int n = tid >> 3, kc = tid & 7, ng = n0 + n;
    int drow;
    if (mode == 0) drow = ng + row_off; else drow = 256 * (ng >> 7) + 128 * (mode - 1) + (ng & 127);
    uint4 o;
    o.x = (unsigned)f2bf(tile[kc * 8 + 0][n]) | ((unsigned)f2bf(tile[kc * 8 + 1][n]) << 16);
    o.y = (unsigned)f2bf(tile[kc * 8 + 2][n]) | ((unsigned)f2bf(tile[kc * 8 + 3][n]) << 16);
    o.z = (unsigned)f2bf(tile[kc * 8 + 4][n]) | ((unsigned)f2bf(tile[kc * 8 + 5][n]) << 16);
    o.w = (unsigned)f2bf(tile[kc * 8 + 6][n]) | ((unsigned)f2bf(tile[kc * 8 + 7][n]) << 16);
    *(uint4*)(WT + (size_t)drow * ldt + k0 + kc * 8) = o;
}
__global__ void __launch_bounds__(512) k_rmsrows(const float* __restrict__ x, const float* __restrict__ g, bf16_t* __restrict__ out, int rows) {
    const int row = blockIdx.x * 8 + (threadIdx.x >> 6), lane = threadIdx.x & 63;
    if (row >= rows) return;
    const float4* xr = (const float4*)(x + (size_t)row * D) + lane;
    float4 v[4]; float s = 0.f;
#pragma unroll
    for (int j = 0; j < 4; ++j) { v[j] = xr[64 * j]; s += v[j].x * v[j].x + v[j].y * v[j].y + v[j].z * v[j].z + v[j].w * v[j].w; }
    const float rs = rsqrtf(wave_sum(s) * (1.f / D) + EPS);
#pragma unroll
    for (int j = 0; j < 4; ++j) {
        const float4 gg = ((const float4*)g)[64 * j + lane];
        uint2 o; o.x = (unsigned)f2bf(v[j].x * rs * gg.x) | ((unsigned)f2bf(v[j].y * rs * gg.y) << 16); o.y = (unsigned)f2bf(v[j].z * rs * gg.z) | ((unsigned)f2bf(v[j].w * rs * gg.w) << 16);
        ((uint2*)(out + (size_t)row * D))[64 * j + lane] = o;
    }
}
__global__ void k_s5tab(const float* a_re, const float* a_im, const float* log_dt, const float* bm_re, const float* bm_im, float* tabE, float* tabB) {
    const int idx = blockIdx.x * blockDim.x + threadIdx.x; if (idx >= S5G * S5P) return;
    const int g = idx / S5P;
    const double dt = exp((double)log_dt[g]), ar = a_re[idx], ai = a_im[idx];
    const double mag = exp(ar * dt), th = ai * dt;
    const double abr = mag * cos(th), abi = mag * sin(th);
    const double nr = abr - 1.0, den = ar * ar + ai * ai;
    const double fre = (nr * ar + abi * ai) / den, fim = (abi * ar - nr * ai) / den;
    double er = 1.0, ei = 0.0;
    for (int t = 0; t <= LC; ++t) { tabE[(idx * 17 + t) * 2] = (float)er; tabE[(idx * 17 + t) * 2 + 1] = (float)ei; const double nr2 = er * abr - ei * abi, ni2 = er * abi + ei * abr; er = nr2; ei = ni2; }
    for (int h = 0; h < S5H; ++h) { const double br = bm_re[idx * S5H + h], bi = bm_im[idx * S5H + h]; tabB[(idx * 16 + h) * 2] = (float)(fre * br - fim * bi); tabB[(idx * 16 + h) * 2 + 1] = (float)(fre * bi + fim * br); }
}
__global__ void __launch_bounds__(256) k_s5mats(const float* __restrict__ tabE, const float* __restrict__ tabB, const float* __restrict__ cm_re, const float* __restrict__ cm_im, const float* __restrict__ d_skip, bf16_t* __restrict__ KmatT, bf16_t* __restrict__ WendT) {
    const int g = blockIdx.y;
    const int e = blockIdx.x * 256 + threadIdx.x;
    const float* E = tabE + (size_t)g * S5P * 17 * 2; const float* Bb = tabB + (size_t)g * S5P * 16 * 2;
    if (e < 256 * KE) {
        const int n = e / KE, k = e % KE, to = n >> 4, h = n & 15; float val = 0.f;
        if (k < 256) {
            const int ti = k >> 4, hp = k & 15;
            if (ti <= to) {
                const int tau = to - ti; float s = 0.f;
                for (int p = 0; p < S5P; ++p) {
                    const float cr = cm_re[(g * 16 + h) * 64 + p], ci = cm_im[(g * 16 + h) * 64 + p];
                    const float er = E[(p * 17 + tau) * 2], ei = E[(p * 17 + tau) * 2 + 1];
                    const float br = Bb[(p * 16 + hp) * 2], bi = Bb[(p * 16 + hp) * 2 + 1];
                    const float xr = er * br - ei * bi, xi = er * bi + ei * br;
                    s += cr * xr - ci * xi;
                }
                if (tau == 0 && hp == h) s += d_skip[g * 16 + h];
                val = s;
            }
        } else {
            const int pp = k - 256, p = pp & 63, im = pp >> 6;
            const float cr = cm_re[(g * 16 + h) * 64 + p], ci = cm_im[(g * 16 + h) * 64 + p];
            const float er = E[(p * 17 + to + 1) * 2], ei = E[(p * 17 + to + 1) * 2 + 1];
            val = im ? -(cr * ei + ci * er) : (cr * er - ci * ei);
        }
        KmatT[(size_t)g * 256 * KE + e] = f2bf(val);
    } else {
        const int e2 = e - 256 * KE; if (e2 >= 128 * 256) return;
        const int pp = e2 >> 8, k = e2 & 255, p = pp & 63, im = pp >> 6, tau = k >> 4, hp = k & 15;
        const float er = E[(p * 17 + (LC - 1 - tau)) * 2], ei = E[(p * 17 + (LC - 1 - tau)) * 2 + 1];
        const float br = Bb[(p * 16 + hp) * 2], bi = Bb[(p * 16 + hp) * 2 + 1];
        WendT[(size_t)g * 128 * 256 + e2] = f2bf(im ? (er * bi + ei * br) : (er * br - ei * bi));
    }
}
__global__ void k_wm(const float* __restrict__ w_s, bf16_t* __restrict__ Wm) {
    const int e = blockIdx.x * blockDim.x + threadIdx.x; if (e >= SGG * SGB * SGB) return;
    const int t = (e >> 7) & 127, s = e & 127; Wm[e] = (s <= t) ? f2bf(w_s[e]) : (bf16_t)0;
}

template <class Epi> __global__ void __launch_bounds__(256) k_ngemm(const bf16_t* __restrict__ A, int lda, const bf16_t* __restrict__ Bt, int ldb, int K, Epi e) {
    const int n = blockIdx.x * 64 + (threadIdx.x & 63), m = blockIdx.y * 4 + (threadIdx.x >> 6);
    e(m, n, dotrow(A + (size_t)m * lda, Bt + (size_t)n * ldb, K));
}
struct EpiInproj {
    bf16_t *Ag, *gu, *gv, *q, *gates; const float* b_gate;
    __device__ void operator()(int m, int n, float acc) const {
        if (n < 512) { const int g = n >> 4; Ag[((size_t)g * NCH + (m >> 4)) * KE + (m & 15) * 16 + (n & 15)] = f2bf(acc); }
        else if (n < 1024) gu[(size_t)m * 512 + n - 512] = f2bf(gelu_t(acc));
        else if (n < 1536) gv[(size_t)m * 512 + n - 1024] = f2bf(gelu_t(acc));
        else if (n < 2048) q[(size_t)m * 512 + n - 1536] = f2bf(acc * 0.08838834764831845f);
        else gates[(size_t)m * 3072 + n - 2048] = f2bf(sigm(acc + b_gate[n - 2048]));
    }
};
struct EpiKV {
    bf16_t *kb, *vT;
    __device__ void operator()(int m, int n, float acc) const {
        if (n < 512) kb[(size_t)m * 512 + n] = f2bf(acc);
        else { const int b = m >> 8, mm = m & 255, hd = n - 512; vT[((size_t)b * 512 + hd) * 256 + mm] = f2bf(acc); }
    }
};
struct EpiGlu {
    const bf16_t* yap; const float* b_glu; bf16_t* yag;
    __device__ void operator()(int m, int n, float acc) const { const float y = bf2f(yap[(size_t)m * 512 + n]); yag[(size_t)m * 512 + n] = f2bf(y * sigm(acc + b_glu[n])); }
};
struct EpiWout {
    const float* x; float* x1; bf16_t* x1b;
    __device__ void operator()(int m, int n, float acc) const { const float v = x[(size_t)m * D + n] + acc; x1[(size_t)m * D + n] = v; x1b[(size_t)m * D + n] = f2bf(v); }
};
struct EpiDown {
    float* x1;
    __device__ void operator()(int m, int n, float acc) const { x1[(size_t)m * D + n] += acc; }
};
__global__ void __launch_bounds__(64) k_s5_naive(const bf16_t* __restrict__ Ag, const float* a_re, const float* a_im, const float* log_dt, const float* bm_re, const float* bm_im,
                                                 const float* cm_re, const float* cm_im, const float* d_skip, bf16_t* __restrict__ yap) {
    const int b = blockIdx.x >> 5, g = blockIdx.x & 31, p = threadIdx.x;
    const float dt = expf(log_dt[g]), ar = a_re[g * 64 + p], ai = a_im[g * 64 + p];
    const float mag = expf(ar * dt), abr = mag * cosf(ai * dt), abi = mag * sinf(ai * dt);
    const float nr = abr - 1.f, den = ar * ar + ai * ai, fre = (nr * ar + abi * ai) / den, fim = (abi * ar - nr * ai) / den;
    float bbr[16], bbi[16], cr[16], ci[16];
#pragma unroll
    for (int h = 0; h < 16; ++h) {
        const float br = bm_re[(g * 64 + p) * 16 + h], bi = bm_im[(g * 64 + p) * 16 + h];
        bbr[h] = fre * br - fim * bi; bbi[h] = fre * bi + fim * br;
        cr[h] = cm_re[(g * 16 + h) * 64 + p]; ci[h] = cm_im[(g * 16 + h) * 64 + p];
    }
    const float dsk = d_skip[g * 16 + (p & 15)];
    float sr = 0.f, si = 0.f;
    for (int t = 0; t < SEQ; ++t) {
        const int tg = b * SEQ + t;
        const bf16_t* up = Ag + ((size_t)g * NCH + (tg >> 4)) * KE + (tg & 15) * 16;
        const uint4 u0 = *(const uint4*)up, u1 = *(const uint4*)(up + 8);
        float u[16];
        u[0] = __uint_as_float(u0.x << 16); u[1] = __uint_as_float(u0.x & 0xffff0000u); u[2] = __uint_as_float(u0.y << 16); u[3] = __uint_as_float(u0.y & 0xffff0000u);
        u[4] = __uint_as_float(u0.z << 16); u[5] = __uint_as_float(u0.z & 0xffff0000u); u[6] = __uint_as_float(u0.w << 16); u[7] = __uint_as_float(u0.w & 0xffff0000u);
        u[8] = __uint_as_float(u1.x << 16); u[9] = __uint_as_float(u1.x & 0xffff0000u); u[10] = __uint_as_float(u1.y << 16); u[11] = __uint_as_float(u1.y & 0xffff0000u);
        u[12] = __uint_as_float(u1.z << 16); u[13] = __uint_as_float(u1.z & 0xffff0000u); u[14] = __uint_as_float(u1.w << 16); u[15] = __uint_as_float(u1.w & 0xffff0000u);
        float bur = 0.f, bui = 0.f;
#pragma unroll
        for (int h = 0; h < 16; ++h) { bur += bbr[h] * u[h]; bui += bbi[h] * u[h]; }
        const float nsr = abr * sr - abi * si + bur, nsi = abr * si + abi * sr + bui; sr = nsr; si = nsi;
        float mine = 0.f, um = 0.f;
#pragma unroll
        for (int h = 0; h < 16; ++h) { const float y = wave_sum(cr[h] * sr - ci[h] * si); if (p == h) { mine = y; um = u[h]; } }
        if (p < 16) yap[(size_t)tg * 512 + g * 16 + p] = f2bf(gelu_t(mine + dsk * um));
    }
}
__global__ void __launch_bounds__(256) k_attn_naive(const bf16_t* __restrict__ q, const bf16_t* __restrict__ kb, const bf16_t* __restrict__ vT, bf16_t* __restrict__ o) {
    __shared__ float sc[256]; __shared__ float red[8];
    const int t = blockIdx.x >> 2, h = blockIdx.x & 3, b = t / SEQ, tid = threadIdx.x, lane = tid & 63, w = tid >> 6;
    const float s = dotrow(q + (size_t)t * 512 + h * 128, kb + (size_t)(b * 256 + tid) * 512 + h * 128, 128);
    float mx = wave_max(s); if (lane == 0) red[w] = mx; __syncthreads();
    mx = fmaxf(fmaxf(red[0], red[1]), fmaxf(red[2], red[3]));
    const float e = expf(s - mx); float sm = wave_sum(e); if (lane == 0) red[4 + w] = sm; __syncthreads();
    sm = red[4] + red[5] + red[6] + red[7];
    sc[tid] = e / sm; __syncthreads();
    if (tid < 128) {
        const bf16_t* vr = vT + ((size_t)b * 512 + h * 128 + tid) * 256; float acc = 0.f;
        for (int m = 0; m < 256; ++m) acc += sc[m] * bf2f(vr[m]);
        o[(size_t)t * 512 + h * 128 + tid] = f2bf(acc);
    }
}
__global__ void __launch_bounds__(512) k_sgu_stats(const bf16_t* __restrict__ gv, float* __restrict__ st) {
    const int row = blockIdx.x * 8 + (threadIdx.x >> 6), lane = threadIdx.x & 63;
    const uint4 r = ((const uint4*)(gv + (size_t)row * 512))[lane];
    float v[8]; v[0] = __uint_as_float(r.x << 16); v[1] = __uint_as_float(r.x & 0xffff0000u); v[2] = __uint_as_float(r.y << 16); v[3] = __uint_as_float(r.y & 0xffff0000u);
    v[4] = __uint_as_float(r.z << 16); v[5] = __uint_as_float(r.z & 0xffff0000u); v[6] = __uint_as_float(r.w << 16); v[7] = __uint_as_float(r.w & 0xffff0000u);
    float s = 0.f;
#pragma unroll
    for (int j = 0; j < 8; ++j) s += v[j];
    const float mu = wave_sum(s) * (1.f / 512.f); float q = 0.f;
#pragma unroll
    for (int j = 0; j < 8; ++j) { const float d = v[j] - mu; q += d * d; }
    const float rstd = rsqrtf(wave_sum(q) * (1.f / 512.f) + EPS);
    if (lane == 0) { st[row * 2] = mu; st[row * 2 + 1] = rstd; }
}
__global__ void __launch_bounds__(256) k_sgu_naive(const bf16_t* __restrict__ gu, const bf16_t* __restrict__ gv, const float* __restrict__ st, const bf16_t* __restrict__ Wm, const float* __restrict__ b_s,
                                                   const float* __restrict__ g_sgu, const float* __restrict__ beta, bf16_t* __restrict__ out) {
    const int c = blockIdx.x * 256 + threadIdx.x, t = blockIdx.y, tt = t & 127, t0 = t - tt, g = c >> 7;
    const float gam = g_sgu[c], bet = beta[c];
    float sv = b_s[g * 128 + tt];
    for (int s = 0; s <= tt; ++s) { const float v = (bf2f(gv[(size_t)(t0 + s) * 512 + c]) - st[(t0 + s) * 2]) * st[(t0 + s) * 2 + 1] * gam + bet; sv += bf2f(Wm[(g * 128 + tt) * 128 + s]) * v; }
    out[(size_t)t * 512 + c] = f2bf(bf2f(gu[(size_t)t * 512 + c]) * sv);
}
__global__ void __launch_bounds__(256) k_merge_naive(const bf16_t* __restrict__ yag, const bf16_t* __restrict__ sgu, const bf16_t* __restrict__ o, const bf16_t* __restrict__ WaT, const bf16_t* __restrict__ WbT,
                                                     const bf16_t* __restrict__ WcT, const bf16_t* __restrict__ gates, bf16_t* __restrict__ merged) {
    const int n = blockIdx.x * 64 + (threadIdx.x & 63), m = blockIdx.y * 4 + (threadIdx.x >> 6);
    const float ya = dotrow(yag + (size_t)m * 512, WaT + (size_t)n * 512, 512), yb = dotrow(sgu + (size_t)m * 512, WbT + (size_t)n * 512, 512), yc = dotrow(o + (size_t)m * 512, WcT + (size_t)n * 512, 512);
    const bf16_t* gr = gates + (size_t)m * 3072 + n;
    merged[(size_t)m * D + n] = f2bf(bf2f(gr[0]) * ya + bf2f(gr[1024]) * yb + bf2f(gr[2048]) * yc);
}
__global__ void __launch_bounds__(256) k_ffnup_naive(const bf16_t* __restrict__ x1b, const bf16_t* __restrict__ WguT, const float* __restrict__ ss1, bf16_t* __restrict__ act) {
    const int j = blockIdx.x * 64 + (threadIdx.x & 63), m = blockIdx.y * 4 + (threadIdx.x >> 6);
    const int r0 = 256 * (j >> 7) + (j & 127);
    const float G = dotrow(x1b + (size_t)m * D, WguT + (size_t)r0 * D, D), U = dotrow(x1b + (size_t)m * D, WguT + (size_t)(r0 + 128) * D, D);
    const float rs = rsqrtf(ss1[m] * (1.f / D) + EPS), gg = rs * G;
    act[(size_t)m * DFF + j] = f2bf(gg * sigm(gg) * (rs * U));
}
__global__ void __launch_bounds__(512) k_rowss(const float* __restrict__ x, float* __restrict__ ss) {
    const int row = blockIdx.x * 8 + (threadIdx.x >> 6), lane = threadIdx.x & 63;
    const float4* xr = (const float4*)(x + (size_t)row * D) + lane; float s = 0.f;
#pragma unroll
    for (int j = 0; j < 4; ++j) { const float4 v = xr[64 * j]; s += v.x * v.x + v.y * v.y + v.z * v.z + v.w * v.w; }
    s = wave_sum(s); if (lane == 0) ss[row] = s;
}
__global__ void __launch_bounds__(256) k_final(float* __restrict__ x, const float* __restrict__ ss, const float* __restrict__ g) {
    const size_t i = (size_t)blockIdx.x * 256 + threadIdx.x; const int row = (int)(i >> 8), c4 = (int)(i & 255);
    const float rs = rsqrtf(ss[row] * (1.f / D) + EPS);
    float4 v = ((float4*)x)[i]; const float4 gg = ((const float4*)g)[c4];
    v.x *= rs * gg.x; v.y *= rs * gg.y; v.z *= rs * gg.z; v.w *= rs * gg.w; ((float4*)x)[i] = v;
}

extern "C" void kernel_launch(void* const* d_in, const int* in_sizes, int n_in, void* d_out, int out_size, void* d_ws, size_t ws_size, hipStream_t stream) {
    if (n_in != 30 || out_size != T * D || ws_size < WS_END) { fprintf(stderr, "kernel_launch: unexpected sizes n_in %d out %d ws %zu\n", n_in, out_size, ws_size); return; }
    const float* x = (const float*)d_in[0]; const float* mem = (const float*)d_in[1]; const float* g_mix = (const float*)d_in[2]; const float* w_in = (const float*)d_in[3];
    const float* b_gate = (const float*)d_in[4]; const float* a_re = (const float*)d_in[5]; const float* a_im = (const float*)d_in[6]; const float* log_dt = (const float*)d_in[7];
    const float* bm_re = (const float*)d_in[8]; const float* bm_im = (const float*)d_in[9]; const float* cm_re = (const float*)d_in[10]; const float* cm_im = (const float*)d_in[11];
    const float* d_skip = (const float*)d_in[12]; const float* w_glu = (const float*)d_in[13]; const float* b_glu = (const float*)d_in[14]; const float* g_sgu = (const float*)d_in[15];
    const float* beta_sgu = (const float*)d_in[16]; const float* w_s = (const float*)d_in[17]; const float* b_s = (const float*)d_in[18]; const float* g_mem = (const float*)d_in[19];
    const float* w_kv = (const float*)d_in[20]; const float* w_a = (const float*)d_in[21]; const float* w_b = (const float*)d_in[22]; const float* w_c = (const float*)d_in[23];
    const float* w_out = (const float*)d_in[24]; const float* g_ffn = (const float*)d_in[25]; const float* w_gate = (const float*)d_in[26]; const float* w_up = (const float*)d_in[27];
    const float* w_down = (const float*)d_in[28]; const float* g_final = (const float*)d_in[29];
    unsigned char* ws = (unsigned char*)d_ws; float* out = (float*)d_out;
    bf16_t* WinT = (bf16_t*)(ws + WS_WIN); bf16_t* WguT = (bf16_t*)(ws + WS_WGU); bf16_t* WdT = (bf16_t*)(ws + WS_WD); bf16_t* WkvT = (bf16_t*)(ws + WS_WKV); bf16_t* WoutT = (bf16_t*)(ws + WS_WOUT);
    bf16_t* WaT = (bf16_t*)(ws + WS_WA); bf16_t* WbT = (bf16_t*)(ws + WS_WB); bf16_t* WcT = (bf16_t*)(ws + WS_WC); bf16_t* WgluT = (bf16_t*)(ws + WS_WGLU);
    bf16_t* KmatT = (bf16_t*)(ws + WS_KMAT); bf16_t* WendT = (bf16_t*)(ws + WS_WEND); bf16_t* Wm = (bf16_t*)(ws + WS_WM); float* tabE = (float*)(ws + WS_TABE); float* tabB = (float*)(ws + WS_TABB);
    float* sgst = (float*)(ws + WS_SGST); bf16_t* memn = (bf16_t*)(ws + WS_MEMN); bf16_t* kb = (bf16_t*)(ws + WS_KB); bf16_t* vT = (bf16_t*)(ws + WS_VT);
    bf16_t* h = (bf16_t*)(ws + WS_R1); bf16_t* yap = (bf16_t*)(ws + WS_R1); bf16_t* merged = (bf16_t*)(ws + WS_R1);
    bf16_t* Ag = (bf16_t*)(ws + WS_R2); bf16_t* yag = (bf16_t*)(ws + WS_R2); bf16_t* x1b = (bf16_t*)(ws + WS_R2); bf16_t* ob = (bf16_t*)(ws + WS_R6);
    bf16_t* gates = (bf16_t*)(ws + WS_R7); bf16_t* act = (bf16_t*)(ws + WS_R7);
    bf16_t* q = (bf16_t*)((unsigned char*)d_out); bf16_t* gu = (bf16_t*)((unsigned char*)d_out + 16 * MiB); bf16_t* gv = (bf16_t*)((unsigned char*)d_out + 32 * MiB); bf16_t* sgu = (bf16_t*)((unsigned char*)d_out + 48 * MiB);
    float* ss1 = (float*)(ws + WS_CTL + CTL_SS1); float* ss2 = (float*)(ws + WS_CTL + CTL_SS2);

    (void)hipMemsetAsync(ws + WS_CTL, 0, 1 * MiB, stream);
    k_tconv<<<dim3(INW / 64, D / 64), 512, 0, stream>>>(w_in, D, INW, WinT, D, nullptr, 0, 0);
    k_tconv<<<dim3(DFF / 64, D / 64), 512, 0, stream>>>(w_gate, D, DFF, WguT, D, g_ffn, 1, 0);
    k_tconv<<<dim3(DFF / 64, D / 64), 512, 0, stream>>>(w_up, D, DFF, WguT, D, g_ffn, 2, 0);
    k_tconv<<<dim3(D / 64, DFF / 64), 512, 0, stream>>>(w_down, DFF, D, WdT, DFF, nullptr, 0, 0);
    k_tconv<<<dim3(1024 / 64, D / 64), 512, 0, stream>>>(w_kv, D, 1024, WkvT, D, nullptr, 0, 0);
    k_tconv<<<dim3(D / 64, D / 64), 512, 0, stream>>>(w_out, D, D, WoutT, D, nullptr, 0, 0);
    k_tconv<<<dim3(D / 64, 512 / 64), 512, 0, stream>>>(w_a, 512, D, WaT, 512, nullptr, 0, 0);
    k_tconv<<<dim3(D / 64, 512 / 64), 512, 0, stream>>>(w_b, 512, D, WbT, 512, nullptr, 0, 0);
    k_tconv<<<dim3(D / 64, 512 / 64), 512, 0, stream>>>(w_c, 512, D, WcT, 512, nullptr, 0, 0);
    k_tconv<<<dim3(512 / 64, 512 / 64), 512, 0, stream>>>(w_glu, 512, 512, WgluT, 512, nullptr, 0, 0);
    k_rmsrows<<<T / 8, 512, 0, stream>>>(x, g_mix, h, T);
    k_rmsrows<<<TM / 8, 512, 0, stream>>>(mem, g_mem, memn, TM);
    k_s5tab<<<(S5G * S5P + 255) / 256, 256, 0, stream>>>(a_re, a_im, log_dt, bm_re, bm_im, tabE, tabB);
    k_s5mats<<<dim3((256 * KE + 128 * 256) / 256, S5G), 256, 0, stream>>>(tabE, tabB, cm_re, cm_im, d_skip, KmatT, WendT);
    k_wm<<<(SGG * SGB * SGB + 255) / 256, 256, 0, stream>>>(w_s, Wm);
    k_ngemm<EpiInproj><<<dim3(INW / 64, T / 4), 256, 0, stream>>>(h, D, WinT, D, D, EpiInproj{Ag, gu, gv, q, gates, b_gate});
    k_ngemm<EpiKV><<<dim3(1024 / 64, TM / 4), 256, 0, stream>>>(memn, D, WkvT, D, D, EpiKV{kb, vT});
    k_s5_naive<<<NB * S5G, 64, 0, stream>>>(Ag, a_re, a_im, log_dt, bm_re, bm_im, cm_re, cm_im, d_skip, yap);
    k_attn_naive<<<T * XH, 256, 0, stream>>>(q, kb, vT, ob);
    k_sgu_stats<<<T / 8, 512, 0, stream>>>(gv, sgst);
    k_sgu_naive<<<dim3(2, T), 256, 0, stream>>>(gu, gv, sgst, Wm, b_s, g_sgu, beta_sgu, sgu);
    k_ngemm<EpiGlu><<<dim3(512 / 64, T / 4), 256, 0, stream>>>(yap, 512, WgluT, 512, 512, EpiGlu{yap, b_glu, yag});
    k_merge_naive<<<dim3(D / 64, T / 4), 256, 0, stream>>>(yag, sgu, ob, WaT, WbT, WcT, gates, merged);
    k_ngemm<EpiWout><<<dim3(D / 64, T / 4), 256, 0, stream>>>(merged, D, WoutT, D, D, EpiWout{x, out, x1b});
    k_rowss<<<T / 8, 512, 0, stream>>>(out, ss1);
    k_ffnup_naive<<<dim3(DFF / 64, T / 4), 256, 0, stream>>>(x1b, WguT, ss1, act);
    k_ngemm<EpiDown><<<dim3(D / 64, T / 4), 256, 0, stream>>>(act, DFF, WdT, DFF, DFF, EpiDown{out});
    k_rowss<<<T / 8, 512, 0, stream>>>(out, ss2);
    k_final<<<T * D / 4 / 256, 256, 0, stream>>>(out, ss2, g_final);
}
```

```cpp
#define MEGA_STAGES (W_PREP|W_INPROJ|W_KV|W_GLU|W_MERGE|W_WOUT|W_FFNUP|W_FFNDOWN|W_FINAL)
#include <hip/hip_runtime.h>
#include <cstdio>
#include <cstdint>

typedef unsigned short bf16_t;
constexpr int NB = 8, SEQ = 2048, D = 1024, T = NB * SEQ, MEML = 256, TM = NB * MEML;
constexpr int S5W = 512, S5G = 32, S5H = 16, S5P = 64, LC = 16, NCH = T / LC, KE = LC * S5H + 2 * S5P;
constexpr int SGW = 512, SGG = 4, SGD = 128, SGB = 128;
constexpr int XH = 4, XD = 128, XW = 512;
constexpr int DFF = 2816, INW = 5120, NGU = 2 * DFF;
constexpr float EPS = 1e-6f;
constexpr size_t MiB = 1u << 20;
constexpr size_t WS_CTL = 0;
constexpr size_t CTL_SS1 = 256 * 1024, CTL_SS2 = 384 * 1024;
constexpr size_t WS_WIN = 1 * MiB, WS_WGU = 11 * MiB, WS_WD = 22 * MiB, WS_WKV = 28 * MiB, WS_WOUT = 30 * MiB;
constexpr size_t WS_WA = 32 * MiB, WS_WB = 33 * MiB, WS_WC = 34 * MiB, WS_WGLU = 35 * MiB, WS_KMAT = 36 * MiB, WS_WEND = 42 * MiB;
constexpr size_t WS_WM = 44 * MiB, WS_TABE = 44 * MiB + 256 * 1024, WS_TABB = 44 * MiB + 512 * 1024, WS_SGST = 45 * MiB;
constexpr size_t WS_MEMN = 46 * MiB, WS_KB = 50 * MiB, WS_VT = 52 * MiB;
constexpr size_t WS_R1 = 56 * MiB;
constexpr size_t WS_R2 = 88 * MiB;
constexpr size_t WS_R6 = 112 * MiB;
constexpr size_t WS_R7 = 128 * MiB;
constexpr size_t WS_END = 224 * MiB;

__device__ __forceinline__ float bf2f(bf16_t v) { return __uint_as_float((unsigned)v << 16); }
__device__ __forceinline__ bf16_t f2bf(float f) { unsigned u = __float_as_uint(f); return (bf16_t)((u + 0x7fffu + ((u >> 16) & 1u)) >> 16); }
__device__ __forceinline__ float gelu_t(float x) { const float u = 0.7978845608028654f * (x + 0.044715f * x * x * x); return 0.5f * x * (1.f + tanhf(u)); }
__device__ __forceinline__ float sigm(float x) { return 1.f / (1.f + expf(-x)); }
__device__ __forceinline__ float wave_sum(float v) {
#pragma unroll
    for (int o = 1; o < 64; o <<= 1) v += __shfl_xor(v, o);
    return v;
}
__device__ __forceinline__ float wave_max(float v) {
#pragma unroll
    for (int o = 1; o < 64; o <<= 1) v = fmaxf(v, __shfl_xor(v, o));
    return v;
}
__device__ __forceinline__ float dot8(uint4 a, uint4 b) {
    float s = 0.f;
    s += __uint_as_float(a.x << 16) * __uint_as_float(b.x << 16) + __uint_as_float(a.x & 0xffff0000u) * __uint_as_float(b.x & 0xffff0000u);
    s += __uint_as_float(a.y << 16) * __uint_as_float(b.y << 16) + __uint_as_float(a.y & 0xffff0000u) * __uint_as_float(b.y & 0xffff0000u);
    s += __uint_as_float(a.z << 16) * __uint_as_float(b.z << 16) + __uint_as_float(a.z & 0xffff0000u) * __uint_as_float(b.z & 0xffff0000u);
    s += __uint_as_float(a.w << 16) * __uint_as_float(b.w << 16) + __uint_as_float(a.w & 0xffff0000u) * __uint_as_float(b.w & 0xffff0000u);
    return s;
}
__device__ __forceinline__ float dotrow(const bf16_t* a, const bf16_t* b, int K) {
    float acc = 0.f;
    for (int k = 0; k < K; k += 8) acc += dot8(*(const uint4*)(a + k), *(const uint4*)(b + k));
    return acc;
}

__global__ void __launch_bounds__(512) k_tconv(const float* __restrict__ W, int K, int N, bf16_t* __restrict__ WT, int ldt, const float* __restrict__ scale, int mode, int row_off) {
    __shared__ float tile[64][65];
    const int n0 = blockIdx.x * 64, k0 = blockIdx.y * 64, tid = threadIdx.x;
#pragma unroll
    for (int i = 0; i < 8; ++i) { const int kk = i * 8 + (tid >> 6), nn = tid & 63; float v = W[(size_t)(k0 + kk) * N + n0 + nn]; if (scale) v *= scale[k0 + kk]; tile[kk][nn] = v; }
    __syncthreads();
    const int n = tid >> 3, kc = tid & 7, ng = n0 + n;
    int drow;
    if (mode == 0) drow = ng + row_off; else drow = 256 * (ng >> 7) + 128 * (mode - 1) + (ng & 127);
    uint4 o;
    o.x = (unsigned)f2bf(tile[kc * 8 + 0][n]) | ((unsigned)f2bf(tile[kc * 8 + 1][n]) << 16);
    o.y = (unsigned)f2bf(tile[kc * 8 + 2][n]) | ((unsigned)f2bf(tile[kc * 8 + 3][n]) << 16);
    o.z = (unsigned)f2bf(tile[kc * 8 + 4][n]) | ((unsigned)f2bf(tile[kc * 8 + 5][n]) << 16);
    o.w = (unsigned)f2bf(tile[kc * 8 + 6][n]) | ((unsigned)f2bf(tile[kc * 8 + 7][n]) << 16);
    *(uint4*)(WT + (size_t)drow * ldt + k0 + kc * 8) = o;
}
__global__ void __launch_bounds__(512) k_rmsrows(const float* __restrict__ x, const float* __restrict__ g, bf16_t* __restrict__ out, int rows) {
    const int row = blockIdx.x * 8 + (threadIdx.x >> 6), lane = threadIdx.x & 63;
    if (row >= rows) return;
    const float4* xr = (const float4*)(x + (size_t)row * D) + lane;
    float4 v[4]; float s = 0.f;
#pragma unroll
    for (int j = 0; j < 4; ++j) { v[j] = xr[64 * j]; s += v[j].x * v[j].x + v[j].y * v[j].y + v[j].z * v[j].z + v[j].w * v[j].w; }
    const float rs = rsqrtf(wave_sum(s) * (1.f / D) + EPS);
#pragma unroll
    for (int j = 0; j < 4; ++j) {
        const float4 gg = ((const float4*)g)[64 * j + lane];
        uint2 o; o.x = (unsigned)f2bf(v[j].x * rs * gg.x) | ((unsigned)f2bf(v[j].y * rs * gg.y) << 16); o.y = (unsigned)f2bf(v[j].z * rs * gg.z) | ((unsigned)f2bf(v[j].w * rs * gg.w) << 16);
        ((uint2*)(out + (size_t)row * D))[64 * j + lane] = o;
    }
}
__global__ void k_s5tab(const float* a_re, const float* a_im, const float* log_dt, const float* bm_re, const float* bm_im, float* tabE, float* tabB) {
    const int idx = blockIdx.x * blockDim.x + threadIdx.x; if (idx >= S5G * S5P) return;
    const int g = idx / S5P;
    const double dt = exp((double)log_dt[g]), ar = a_re[idx], ai = a_im[idx];
    const double mag = exp(ar * dt), th = ai * dt;
    const double abr = mag * cos(th), abi = mag * sin(th);
    const double nr = abr - 1.0, den = ar * ar + ai * ai;
    const double fre = (nr * ar + abi * ai) / den, fim = (abi * ar - nr * ai) / den;
    double er = 1.0, ei = 0.0;
    for (int t = 0; t <= LC; ++t) { tabE[(idx * 17 + t) * 2] = (float)er; tabE[(idx * 17 + t) * 2 + 1] = (float)ei; const double nr2 = er * abr - ei * abi, ni2 = er * abi + ei * abr; er = nr2; ei = ni2; }
    for (int h = 0; h < S5H; ++h) { const double br = bm_re[idx * S5H + h], bi = bm_im[idx * S5H + h]; tabB[(idx * 16 + h) * 2] = (float)(fre * br - fim * bi); tabB[(idx * 16 + h) * 2 + 1] = (float)(fre * bi + fim * br); }
}
__global__ void __launch_bounds__(256) k_s5mats(const float* __restrict__ tabE, const float* __restrict__ tabB, const float* __restrict__ cm_re, const float* __restrict__ cm_im, const float* __restrict__ d_skip, bf16_t* __restrict__ KmatT, bf16_t* __restrict__ WendT) {
    const int g = blockIdx.y;
    const int e = blockIdx.x * 256 + threadIdx.x;
    const float* E = tabE + (size_t)g * S5P * 17 * 2; const float* Bb = tabB + (size_t)g * S5P * 16 * 2;
    if (e < 256 * KE) {
        const int n = e / KE, k = e % KE, to = n >> 4, h = n & 15; float val = 0.f;
        if (k < 256) {
            const int ti = k >> 4, hp = k & 15;
            if (ti <= to) {
                const int tau = to - ti; float s = 0.f;
                for (int p = 0; p < S5P; ++p) {
                    const float cr = cm_re[(g * 16 + h) * 64 + p], ci = cm_im[(g * 16 + h) * 64 + p];
                    const float er = E[(p * 17 + tau) * 2], ei = E[(p * 17 + tau) * 2 + 1];
                    const float br = Bb[(p * 16 + hp) * 2], bi = Bb[(p * 16 + hp) * 2 + 1];
                    const float xr = er * br - ei * bi, xi = er * bi + ei * br;
                    s += cr * xr - ci * xi;
                }
                if (tau == 0 && hp == h) s += d_skip[g * 16 + h];
                val = s;
            }
        } else {
            const int pp = k - 256, p = pp & 63, im = pp >> 6;
            const float cr = cm_re[(g * 16 + h) * 64 + p], ci = cm_im[(g * 16 + h) * 64 + p];
            const float er = E[(p * 17 + to + 1) * 2], ei = E[(p * 17 + to + 1) * 2 + 1];
            val = im ? -(cr * ei + ci * er) : (cr * er - ci * ei);
        }
        KmatT[(size_t)g * 256 * KE + e] = f2bf(val);
    } else {
        const int e2 = e - 256 * KE; if (e2 >= 128 * 256) return;
        const int pp = e2 >> 8, k = e2 & 255, p = pp & 63, im = pp >> 6, tau = k >> 4, hp = k & 15;
        const float er = E[(p * 17 + (LC - 1 - tau)) * 2], ei = E[(p * 17 + (LC - 1 - tau)) * 2 + 1];
        const float br = Bb[(p * 16 + hp) * 2], bi = Bb[(p * 16 + hp) * 2 + 1];
        WendT[(size_t)g * 128 * 256 + e2] = f2bf(im ? (er * bi + ei * br) : (er * br - ei * bi));
    }
}
__global__ void k_wm(const float* __restrict__ w_s, bf16_t* __restrict__ Wm) {
    const int e = blockIdx.x * blockDim.x + threadIdx.x; if (e >= SGG * SGB * SGB) return;
    const int t = (e >> 7) & 127, s = e & 127; Wm[e] = (s <= t) ? f2bf(w_s[e]) : (bf16_t)0;
}

template <class Epi> __global__ void __launch_bounds__(256) k_ngemm(const bf16_t* __restrict__ A, int lda, const bf16_t* __restrict__ Bt, int ldb, int K, Epi e) {
    const int n = blockIdx.x * 64 + (threadIdx.x & 63), m = blockIdx.y * 4 + (threadIdx.x >> 6);
    e(m, n, dotrow(A + (size_t)m * lda, Bt + (size_t)n * ldb, K));
}
struct EpiInproj {
    bf16_t *Ag, *gu, *gv, *q, *gates; const float* b_gate;
    __device__ void operator()(int m, int n, float acc) const {
        if (n < 512) { const int g = n >> 4; Ag[((size_t)g * NCH + (m >> 4)) * KE + (m & 15) * 16 + (n & 15)] = f2bf(acc); }
        else if (n < 1024) gu[(size_t)m * 512 + n - 512] = f2bf(gelu_t(acc));
        else if (n < 1536) gv[(size_t)m * 512 + n - 1024] = f2bf(gelu_t(acc));
        else if (n < 2048) q[(size_t)m * 512 + n - 1536] = f2bf(acc * 0.08838834764831845f);
        else gates[(size_t)m * 3072 + n - 2048] = f2bf(sigm(acc + b_gate[n - 2048]));
    }
};
struct EpiKV {
    bf16_t *kb, *vT;
    __device__ void operator()(int m, int n, float acc) const {
        if (n < 512) kb[(size_t)m * 512 + n] = f2bf(acc);
        else { const int b = m >> 8, mm = m & 255, hd = n - 512; vT[((size_t)b * 512 + hd) * 256 + mm] = f2bf(acc); }
    }
};
struct EpiGlu {
    const bf16_t* yap; const float* b_glu; bf16_t* yag;
    __device__ void operator()(int m, int n, float acc) const { const float y = bf2f(yap[(size_t)m * 512 + n]); yag[(size_t)m * 512 + n] = f2bf(y * sigm(acc + b_glu[n])); }
};
struct EpiWout {
    const float* x; float* x1; bf16_t* x1b;
    __device__ void operator()(int m, int n, float acc) const { const float v = x[(size_t)m * D + n] + acc; x1[(size_t)m * D + n] = v; x1b[(size_t)m * D + n] = f2bf(v); }
};
struct EpiDown {
    float* x1;
    __device__ void operator()(int m, int n, float acc) const { x1[(size_t)m * D + n] += acc; }
};
__global__ void __launch_bounds__(64) k_s5_naive(const bf16_t* __restrict__ Ag, const float* a_re, const float* a_im, const float* log_dt, const float* bm_re, const float* bm_im,
                                                 const float* cm_re, const float* cm_im, const float* d_skip, bf16_t* __restrict__ yap) {
    const int b = blockIdx.x >> 5, g = blockIdx.x & 31, p = threadIdx.x;
    const float dt = expf(log_dt[g]), ar = a_re[g * 64 + p], ai = a_im[g * 64 + p];
    const float mag = expf(ar * dt), abr = mag * cosf(ai * dt), abi = mag * sinf(ai * dt);
    const float nr = abr - 1.f, den = ar * ar + ai * ai, fre = (nr * ar + abi * ai) / den, fim = (abi * ar - nr * ai) / den;
    float bbr[16], bbi[16], cr[16], ci[16];
#pragma unroll
    for (int h = 0; h < 16; ++h) {
        const float br = bm_re[(g * 64 + p) * 16 + h], bi = bm_im[(g * 64 + p) * 16 + h];
        bbr[h] = fre * br - fim * bi; bbi[h] = fre * bi + fim * br;
        cr[h] = cm_re[(g * 16 + h) * 64 + p]; ci[h] = cm_im[(g * 16 + h) * 64 + p];
    }
    const float dsk = d_skip[g * 16 + (p & 15)];
    float sr = 0.f, si = 0.f;
    for (int t = 0; t < SEQ; ++t) {
        const int tg = b * SEQ + t;
        const bf16_t* up = Ag + ((size_t)g * NCH + (tg >> 4)) * KE + (tg & 15) * 16;
        const uint4 u0 = *(const uint4*)up, u1 = *(const uint4*)(up + 8);
        float u[16];
        u[0] = __uint_as_float(u0.x << 16); u[1] = __uint_as_float(u0.x & 0xffff0000u); u[2] = __uint_as_float(u0.y << 16); u[3] = __uint_as_float(u0.y & 0xffff0000u);
        u[4] = __uint_as_float(u0.z << 16); u[5] = __uint_as_float(u0.z & 0xffff0000u); u[6] = __uint_as_float(u0.w << 16); u[7] = __uint_as_float(u0.w & 0xffff0000u);
        u[8] = __uint_as_float(u1.x << 16); u[9] = __uint_as_float(u1.x & 0xffff0000u); u[10] = __uint_as_float(u1.y << 16); u[11] = __uint_as_float(u1.y & 0xffff0000u);
        u[12] = __uint_as_float(u1.z << 16); u[13] = __uint_as_float(u1.z & 0xffff0000u); u[14] = __uint_as_float(u1.w << 16); u[15] = __uint_as_float(u1.w & 0xffff0000u);
        float bur = 0.f, bui = 0.f;
#pragma unroll
        for (int h = 0; h < 16; ++h) { bur += bbr[h] * u[h]; bui += bbi[h] * u[h]; }
        const float nsr = abr * sr - abi * si + bur, nsi = abr * si + abi * sr + bui; sr = nsr; si = nsi;
        float mine = 0.f, um = 0.f;
#pragma unroll
        for (int h = 0; h < 16; ++h) { const float y = wave_sum(cr[h] * sr - ci[h] * si); if (p == h) { mine = y; um = u[h]; } }
        if (p < 16) yap[(size_t)tg * 512 + g * 16 + p] = f2bf(gelu_t(mine + dsk * um));
    }
}
__global__ void __launch_bounds__(256) k_attn_naive(const bf16_t* __restrict__ q, const bf16_t* __restrict__ kb, const bf16_t* __restrict__ vT, bf16_t* __restrict__ o) {
    __shared__ float sc[256]; __shared__ float red[8];
    const int t = blockIdx.x >> 2, h = blockIdx.x & 3, b = t / SEQ, tid = threadIdx.x, lane = tid & 63, w = tid >> 6;
    const float s = dotrow(q + (size_t)t * 512 + h * 128, kb + (size_t)(b * 256 + tid) * 512 + h * 128, 128);
    float mx = wave_max(s); if (lane == 0) red[w] = mx; __syncthreads();
    mx = fmaxf(fmaxf(red[0], red[1]), fmaxf(red[2], red[3]));
    const float e = expf(s - mx); float sm = wave_sum(e); if (lane == 0) red[4 + w] = sm; __syncthreads();
    sm = red[4] + red[5] + red[6] + red[7];
    sc[tid] = e / sm; __syncthreads();
    if (tid < 128) {
        const bf16_t* vr = vT + ((size_t)b * 512 + h * 128 + tid) * 256; float acc = 0.f;
        for (int m = 0; m < 256; ++m) acc += sc[m] * bf2f(vr[m]);
        o[(size_t)t * 512 + h * 128 + tid] = f2bf(acc);
    }
}
__global__ void __launch_bounds__(512) k_sgu_stats(const bf16_t* __restrict__ gv, float* __restrict__ st) {
    const int row = blockIdx.x * 8 + (threadIdx.x >> 6), lane = threadIdx.x & 63;
    const uint4 r = ((const uint4*)(gv + (size_t)row * 512))[lane];
    float v[8]; v[0] = __uint_as_float(r.x << 16); v[1] = __uint_as_float(r.x & 0xffff0000u); v[2] = __uint_as_float(r.y << 16); v[3] = __uint_as_float(r.y & 0xffff0000u);
    v[4] = __uint_as_float(r.z << 16); v[5] = __uint_as_float(r.z & 0xffff0000u); v[6] = __uint_as_float(r.w << 16); v[7] = __uint_as_float(r.w & 0xffff0000u);
    float s = 0.f;
#pragma unroll
    for (int j = 0; j < 8; ++j) s += v[j];
    const float mu = wave_sum(s) * (1.f / 512.f); float q = 0.f;
#pragma unroll
    for (int j = 0; j < 8; ++j) { const float d = v[j] - mu; q += d * d; }
    const float rstd = rsqrtf(wave_sum(q) * (1.f / 512.f) + EPS);
    if (lane == 0) { st[row * 2] = mu; st[row * 2 + 1] = rstd; }
}
__global__ void __launch_bounds__(256) k_sgu_naive(const bf16_t* __restrict__ gu, const bf16_t* __restrict__ gv, const float* __restrict__ st, const bf16_t* __restrict__ Wm, const float* __restrict__ b_s,
                                                   const float* __restrict__ g_sgu, const float* __restrict__ beta, bf16_t* __restrict__ out) {
    const int c = blockIdx.x * 256 + threadIdx.x, t = blockIdx.y, tt = t & 127, t0 = t - tt, g = c >> 7;
    const float gam = g_sgu[c], bet = beta[c];
    float sv = b_s[g * 128 + tt];
    for (int s = 0; s <= tt; ++s) { const float v = (bf2f(gv[(size_t)(t0 + s) * 512 + c]) - st[(t0 + s) * 2]) * st[(t0 + s) * 2 + 1] * gam + bet; sv += bf2f(Wm[(g * 128 + tt) * 128 + s]) * v; }
    out[(size_t)t * 512 + c] = f2bf(bf2f(gu[(size_t)t * 512 + c]) * sv);
}
__global__ void __launch_bounds__(256) k_merge_naive(const bf16_t* __restrict__ yag, const bf16_t* __restrict__ sgu, const bf16_t* __restrict__ o, const bf16_t* __restrict__ WaT, const bf16_t* __restrict__ WbT,
                                                     const bf16_t* __restrict__ WcT, const bf16_t* __restrict__ gates, bf16_t* __restrict__ merged) {
    const int n = blockIdx.x * 64 + (threadIdx.x & 63), m = blockIdx.y * 4 + (threadIdx.x >> 6);
    const float ya = dotrow(yag + (size_t)m * 512, WaT + (size_t)n * 512, 512), yb = dotrow(sgu + (size_t)m * 512, WbT + (size_t)n * 512, 512), yc = dotrow(o + (size_t)m * 512, WcT + (size_t)n * 512, 512);
    const bf16_t* gr = gates + (size_t)m * 3072 + n;
    merged[(size_t)m * D + n] = f2bf(bf2f(gr[0]) * ya + bf2f(gr[1024]) * yb + bf2f(gr[2048]) * yc);
}
__global__ void __launch_bounds__(256) k_ffnup_naive(const bf16_t* __restrict__ x1b, const bf16_t* __restrict__ WguT, const float* __restrict__ ss1, bf16_t* __restrict__ act) {
    const int j = blockIdx.x * 64 + (threadIdx.x & 63), m = blockIdx.y * 4 + (threadIdx.x >> 6);
    const int r0 = 256 * (j >> 7) + (j & 127);
    const float G = dotrow(x1b + (size_t)m * D, WguT + (size_t)r0 * D, D), U = dotrow(x1b + (size_t)m * D, WguT + (size_t)(r0 + 128) * D, D);
    const float rs = rsqrtf(ss1[m] * (1.f / D) + EPS), gg = rs * G;
    act[(size_t)m * DFF + j] = f2bf(gg * sigm(gg) * (rs * U));
}
__global__ void __launch_bounds__(512) k_rowss(const float* __restrict__ x, float* __restrict__ ss) {
    const int row = blockIdx.x * 8 + (threadIdx.x >> 6), lane = threadIdx.x & 63;
    const float4* xr = (const float4*)(x + (size_t)row * D) + lane; float s = 0.f;
#pragma unroll
    for (int j = 0; j < 4; ++j) { const float4 v = xr[64 * j]; s += v.x * v.x + v.y * v.y + v.z * v.z + v.w * v.w; }
    s = wave_sum(s); if (lane == 0) ss[row] = s;
}
__global__ void __launch_bounds__(256) k_final(float* __restrict__ x, const float* __restrict__ ss, const float* __restrict__ g) {
    const size_t i = (size_t)blockIdx.x * 256 + threadIdx.x; const int row = (int)(i >> 8), c4 = (int)(i & 255);
    const float rs = rsqrtf(ss[row] * (1.f / D) + EPS);
    float4 v = ((float4*)x)[i]; const float4 gg = ((const float4*)g)[c4];
    v.x *= rs * gg.x; v.y *= rs * gg.y; v.z *= rs * gg.z; v.w *= rs * gg.w; ((float4*)x)[i] = v;
}

#define LAS __attribute__((address_space(3)))
typedef short bf16x8 __attribute__((ext_vector_type(8)));
typedef float f32x4 __attribute__((ext_vector_type(4)));
typedef float f32x2 __attribute__((ext_vector_type(2)));
typedef unsigned u32x4 __attribute__((ext_vector_type(4)));
typedef unsigned u32x2 __attribute__((ext_vector_type(2)));
typedef __bf16 bf16x2_t __attribute__((ext_vector_type(2)));

constexpr int NWAVES = 8, NTHREADS = 512;
constexpr int BM = 256, BK = 64, HALF = 128, HTB = HALF * BK * 2, NXCD = 8, WGM = 8;
constexpr int RING_BYTES = 131072, LDSCTL_OFF = RING_BYTES, LDS_BYTES = 147456;
constexpr int CW_BAR = 4096;
enum { W_PREP = 1, W_INPROJ = 2, W_KV = 4, W_S5L = 8, W_SGU = 16, W_S5Y = 32, W_ATTN = 64, W_GLU = 128, W_MERGE = 256, W_WOUT = 512, W_FFNUP = 1024, W_FFNDOWN = 2048, W_FINAL = 4096, W_ALL = 8191 };

#define LDS_WAIT() asm volatile("s_waitcnt lgkmcnt(0)" ::: "memory")
#define VM_WAIT() asm volatile("s_waitcnt vmcnt(0)" ::: "memory")
__device__ __forceinline__ unsigned cvtpk(float lo, float hi) { f32x2 v = {lo, hi}; bf16x2_t b = __builtin_convertvector(v, bf16x2_t); return __builtin_bit_cast(unsigned, b); }
__device__ __forceinline__ u32x4 pack8(const f32x4 a, const f32x4 b) { u32x4 w; w.x = cvtpk(a[0], a[1]); w.y = cvtpk(a[2], a[3]); w.z = cvtpk(b[0], b[1]); w.w = cvtpk(b[2], b[3]); return w; }
__device__ __forceinline__ f32x4 unpk_lo(const u32x4 w) { return (f32x4){__uint_as_float(w.x << 16), __uint_as_float(w.x & 0xffff0000u), __uint_as_float(w.y << 16), __uint_as_float(w.y & 0xffff0000u)}; }
__device__ __forceinline__ f32x4 unpk_hi(const u32x4 w) { return (f32x4){__uint_as_float(w.z << 16), __uint_as_float(w.z & 0xffff0000u), __uint_as_float(w.w << 16), __uint_as_float(w.w & 0xffff0000u)}; }
__device__ __forceinline__ float sigm_f(float x) { return __builtin_amdgcn_rcpf(1.f + __builtin_amdgcn_exp2f(-1.4426950408889634f * x)); }
__device__ __forceinline__ float gelu_f(float x) { const float u2 = 1.5957691216057308f * (x + 0.044715f * x * x * x); return x * sigm_f(u2); }
__device__ __forceinline__ f32x4 gelu4(const f32x4 v) { return (f32x4){gelu_f(v[0]), gelu_f(v[1]), gelu_f(v[2]), gelu_f(v[3])}; }
__device__ __forceinline__ f32x4 sigm4(const f32x4 v) { return (f32x4){sigm_f(v[0]), sigm_f(v[1]), sigm_f(v[2]), sigm_f(v[3])}; }
__device__ __forceinline__ f32x4 rcp4(const f32x4 v) { return (f32x4){__builtin_amdgcn_rcpf(v[0]), __builtin_amdgcn_rcpf(v[1]), __builtin_amdgcn_rcpf(v[2]), __builtin_amdgcn_rcpf(v[3])}; }

#define XB_TMO      128
#define XB_XCNT(j)  (256  + 64 * (j))
#define XB_XSUB(j)  (1280 + 64 * (j))
#define XB_XGEN(j)  (2304 + 64 * (j))
#define XB_TOP      3328
#define XB_TOPGEN   3392
#define XCD_BAR_WORDS 3456
#define XB_SPIN_CAP (1u << 18)
__device__ __forceinline__ unsigned xb_ld(unsigned* p)              { return __hip_atomic_load(p, __ATOMIC_RELAXED, __HIP_MEMORY_SCOPE_AGENT); }
__device__ __forceinline__ unsigned xb_add(unsigned* p, unsigned v) { return __hip_atomic_fetch_add(p, v, __ATOMIC_RELAXED, __HIP_MEMORY_SCOPE_AGENT); }
__device__ __forceinline__ unsigned xb_xcc_id() { return (unsigned)__builtin_amdgcn_s_getreg((3 << 11) | 20) & 0xFu; }
#define XB_SPIN(cond, bar) do { unsigned _sp = 0; while (cond) { __builtin_amdgcn_s_sleep(1); \
    if ((++_sp & 255u) == 0u) { if (xb_ld(&(bar)[XB_TMO])) break; if (_sp > XB_SPIN_CAP) { atomicAdd(&(bar)[XB_TMO], 1u); break; } } } } while (0)
struct XcdBarrier { unsigned* bar; unsigned x; volatile LAS unsigned* st; };
__device__ __forceinline__ XcdBarrier xcd_barrier_post(unsigned* bar, volatile LAS unsigned* st) {
    XcdBarrier b; b.bar = bar; b.x = xb_xcc_id(); b.st = st;
    if (threadIdx.x == 0) (void)xb_add(&bar[XB_XCNT(b.x)], 1u);
    return b;
}
__device__ __forceinline__ void xcd_barrier_complete(unsigned* bar, unsigned x, unsigned& nloc, unsigned& nx) {
    const unsigned G = gridDim.x * gridDim.y * gridDim.z;
    unsigned sum, cnt, mine, sp = 0u;
    for (;;) {
        sum = 0u; cnt = 0u; mine = 0u;
#pragma unroll
        for (unsigned j = 0; j < 16; ++j) { const unsigned c = xb_ld(&bar[XB_XCNT(j)]); sum += c; cnt += (c > 0u) ? 1u : 0u; mine = (j == x) ? c : mine; }
        if (sum == G) break;
        __builtin_amdgcn_s_sleep(1);
        if ((++sp & 255u) == 0u) { if (xb_ld(&bar[XB_TMO])) break; if (sp > XB_SPIN_CAP) { atomicAdd(&bar[XB_TMO], 1u); break; } }
    }
    nloc = mine > 0u ? mine : 1u; nx = cnt > 0u ? cnt : 1u;
}
__device__ __forceinline__ void xcd_barrier(const XcdBarrier& b) {
    asm volatile("s_waitcnt vmcnt(0)" ::: "memory");
    __syncthreads();
    if (threadIdx.x == 0) {
        unsigned* bar = b.bar;
        __builtin_amdgcn_s_waitcnt(0);
        unsigned nloc = b.st[0], nx = b.st[1];
        if (nloc == 0u) { xcd_barrier_complete(bar, b.x, nloc, nx); b.st[0] = nloc; b.st[1] = nx; }
        const unsigned old = xb_add(&bar[XB_XSUB(b.x)], 1u);
        const unsigned gen = old / nloc;
        if (old + 1u == (gen + 1u) * nloc) {
            __builtin_amdgcn_fence(__ATOMIC_RELEASE, "agent");
            asm volatile("s_waitcnt vmcnt(0)" ::: "memory");
            const unsigned og = xb_add(&bar[XB_TOP], 1u);
            const unsigned tg = og / nx;
            if (og + 1u == (tg + 1u) * nx) xb_add(&bar[XB_TOPGEN], 1u);
            else XB_SPIN(xb_ld(&bar[XB_TOPGEN]) == tg, bar);
            __builtin_amdgcn_fence(__ATOMIC_ACQUIRE, "agent");
            xb_add(&bar[XB_XGEN(b.x)], 1u);
            asm volatile("s_waitcnt vmcnt(0)" ::: "memory");
        } else {
            XB_SPIN(xb_ld(&bar[XB_XGEN(b.x)]) == gen, bar);
            __builtin_amdgcn_fence(__ATOMIC_ACQUIRE, "agent");
            asm volatile("s_waitcnt vmcnt(0)" ::: "memory");
        }
    }
    __syncthreads();
}

__host__ __device__ __forceinline__ int lds_byte(int r, int c) { const int st = (r >> 4) * 2 + (c >> 5), rr = r & 15, cc = c & 31, ob = rr * 64 + cc * 2; return st * 1024 + (ob ^ (((ob >> 9) & 1) << 5)); }
__host__ __device__ __forceinline__ void stage_rc(int b, int& R, int& C) { const int st = b / 1024, sb = b % 1024, swz = sb ^ (((sb >> 9) & 1) << 5); R = (st >> 1) * 16 + swz / 64; C = (st & 1) * 32 + (swz % 64) / 2; }
__host__ __device__ __forceinline__ int perm32(int rho) { const int n = rho >> 4, i = rho & 15; return 8 * (i >> 2) + 4 * n + (i & 3); }
struct Unit { const char* a; const char* b; int pm, pn, sub; };

struct TileOrder {
    int nM, nN, nwg, G, c; const char* A; const char* B; size_t ta, tb;
    __device__ __forceinline__ void init(int M, int N, int G_, int c_, const void* A_, int lda, const void* B_, int ldb) { nM = M / BM; nN = N / BM; nwg = nM * nN; G = G_; c = c_; A = (const char*)A_; B = (const char*)B_; ta = (size_t)BM * lda * 2; tb = (size_t)BM * ldb * 2; }
    __device__ __forceinline__ bool tile(long L, int& pm, int& pn) const {
        if (L >= nwg) return false;
        int wgid = (int)L; { const int q = nwg / NXCD, r = nwg % NXCD, xcd = wgid % NXCD, off = wgid / NXCD; wgid = (xcd < r ? xcd * (q + 1) : r * (q + 1) + (xcd - r) * q) + off; }
        const int nig = WGM * nN, gid = wgid / nig, fm = gid * WGM, gsz = (nM - fm) < WGM ? (nM - fm) : WGM;
        pm = fm + ((wgid % nig) % gsz); pn = (wgid % nig) / gsz; return true;
    }
    __device__ __forceinline__ bool next(int i, Unit& u) const { if (!tile((long)i * G + c, u.pm, u.pn)) return false; u.a = A + (size_t)u.pm * ta; u.b = B + (size_t)u.pn * tb; u.sub = 0; return true; }
};

template <class Epi, class Sched>
__device__ __forceinline__ void gemm_phase(LAS unsigned char* lds, const int lda, const int ldb, const int nt, const Sched S, const Epi E) {
    const int tid = threadIdx.x, wid = __builtin_amdgcn_readfirstlane(tid >> 6), lane = tid & 63, wr = wid >> 2, wc = wid & 3, fr = lane & 15, fq = lane >> 4;
    unsigned voffA[2], voffB[2];
#pragma unroll
    for (int i = 0; i < 2; ++i) { int R, C; stage_rc(tid * 16 + i * 8192, R, C); const int Rb = Epi::PERM ? ((R & ~31) + perm32(R & 31)) : R;
        voffA[i] = (unsigned)(R * lda + C) * 2u; voffB[i] = (unsigned)(Rb * ldb + C) * 2u; }
    const size_t kstep = (size_t)(BK * 2);
    const size_t hstepA = (size_t)HALF * lda * 2, hstepB = (size_t)HALF * ldb * 2;
    const unsigned ldsw = (unsigned)wid * 1024u;
    const int aoff = lds_byte(wr * 64 + fr, fq * 8), boff = lds_byte(wc * 32 + fr, fq * 8);
#define PG8_SA(b, h) (((b) * 2 + (h)) * HTB)
#define PG8_SB(b, h) ((4 + (b) * 2 + (h)) * HTB)
#define PG8_STAGE(bufoff, gbase, voff) do { _Pragma("unroll") for (int _i = 0; _i < 2; ++_i) \
        __builtin_amdgcn_global_load_lds((const unsigned*)((const char*)(gbase) + (voff)[_i]), (LAS unsigned*)(lds + (bufoff) + ldsw + _i * 8192), 16, 0, 0); } while (0)
#define PG8_LDA(dst, b, h) do { _Pragma("unroll") for (int m = 0; m < 4; ++m) _Pragma("unroll") for (int k = 0; k < 2; ++k) dst[m][k] = *(const LAS bf16x8*)(lds + PG8_SA(b, h) + aoff + m * 2048 + k * 1024); } while (0)
#define PG8_LDB(dst, b, h) do { _Pragma("unroll") for (int n = 0; n < 2; ++n) _Pragma("unroll") for (int k = 0; k < 2; ++k) dst[n][k] = *(const LAS bf16x8*)(lds + PG8_SB(b, h) + boff + n * 2048 + k * 1024); } while (0)
#define PG8_MMA(ai, bj, At, Bt) do { __builtin_amdgcn_s_setprio(1); _Pragma("unroll") for (int m = 0; m < 4; ++m) _Pragma("unroll") for (int n = 0; n < 2; ++n) _Pragma("unroll") for (int k = 0; k < 2; ++k) \
        acc[ai][bj][m][n] = __builtin_amdgcn_mfma_f32_16x16x32_bf16(Bt[n][k], At[m][k], acc[ai][bj][m][n], 0, 0, 0); __builtin_amdgcn_s_setprio(0); } while (0)
#define PG8_WAIT_V(n) asm volatile("s_waitcnt vmcnt(" #n ")" ::: "memory")
#define PG8_WAIT_L(n) asm volatile("s_waitcnt lgkmcnt(" #n ")" ::: "memory")
#define PG8_BAR __builtin_amdgcn_s_barrier()
#define PG8_SCHED __builtin_amdgcn_sched_barrier(0)
    Unit cur, nxt; int ui = 0;
    if (!S.next(0, cur)) return;
    f32x4 acc[2][2][4][2];
#pragma unroll
    for (int a = 0; a < 2; ++a)
#pragma unroll
        for (int b = 0; b < 2; ++b)
#pragma unroll
            for (int m = 0; m < 4; ++m)
#pragma unroll
                for (int n = 0; n < 2; ++n) acc[a][b][m][n] = (f32x4){0.f, 0.f, 0.f, 0.f};
    bf16x8 At[4][2], B0[2][2], B1[2][2];
    const char* cA = cur.a; const char* cB = cur.b;
    PG8_STAGE(PG8_SB(0, 0), cB, voffB); PG8_STAGE(PG8_SB(0, 1), cB + hstepB, voffB); PG8_STAGE(PG8_SA(0, 0), cA, voffA); PG8_STAGE(PG8_SA(0, 1), cA + hstepA, voffA);
    if (wr == 1) PG8_BAR;
    PG8_WAIT_V(2); PG8_BAR;
    PG8_STAGE(PG8_SB(1, 0), cB + kstep, voffB); PG8_STAGE(PG8_SA(1, 0), cA + kstep, voffA); PG8_STAGE(PG8_SB(1, 1), cB + hstepB + kstep, voffB);
    PG8_WAIT_V(6); PG8_BAR;
    for (;;) {
        const bool has_next = S.next(ui + 1, nxt);
        const char* nA = has_next ? nxt.a : cA; const char* nB = has_next ? nxt.b : cB;
#pragma unroll 1
        for (int t = 0; t < nt; t += 2) {
            const bool last = (t == nt - 2);
            const char* a1 = cA + (size_t)(t + 1) * kstep;
            const char* a2 = last ? nA : cA + (size_t)(t + 2) * kstep; const char* b2 = last ? nB : cB + (size_t)(t + 2) * kstep;
            const char* a3 = a2 + kstep; const char* b3 = b2 + kstep;
            PG8_LDB(B0, 0, 0); PG8_LDB(B1, 0, 1); PG8_SCHED; PG8_LDA(At, 0, 0); PG8_STAGE(PG8_SA(1, 1), a1 + hstepA, voffA);
            PG8_WAIT_V(8); PG8_WAIT_L(0); PG8_BAR; PG8_MMA(0, 0, At, B0); PG8_MMA(0, 1, At, B1); PG8_BAR; PG8_SCHED;
            PG8_LDA(At, 0, 1); PG8_STAGE(PG8_SB(0, 0), b2, voffB); PG8_STAGE(PG8_SB(0, 1), b2 + hstepB, voffB); PG8_STAGE(PG8_SA(0, 0), a2, voffA);
            PG8_WAIT_V(8); PG8_WAIT_L(0); PG8_BAR; PG8_MMA(1, 0, At, B0); PG8_MMA(1, 1, At, B1); PG8_BAR; PG8_SCHED;
            PG8_LDB(B0, 1, 0); PG8_LDB(B1, 1, 1); PG8_SCHED; PG8_LDA(At, 1, 0); PG8_STAGE(PG8_SA(0, 1), a2 + hstepA, voffA);
            PG8_WAIT_V(8); PG8_WAIT_L(0); PG8_BAR; PG8_MMA(0, 0, At, B0); PG8_MMA(0, 1, At, B1); PG8_BAR; PG8_SCHED;
            PG8_LDA(At, 1, 1); PG8_STAGE(PG8_SB(1, 0), b3, voffB); PG8_STAGE(PG8_SB(1, 1), b3 + hstepB, voffB); PG8_STAGE(PG8_SA(1, 0), a3, voffA);
            PG8_WAIT_V(8); PG8_WAIT_L(0); PG8_BAR; PG8_MMA(1, 0, At, B0); PG8_MMA(1, 1, At, B1); PG8_BAR; PG8_SCHED;
        }
        if (wr == 0) PG8_BAR;
        const bool reset = E(acc, cur, wr, wc, fr, fq);
        if (!has_next) break;
        if (reset) {
#pragma unroll
            for (int a = 0; a < 2; ++a)
#pragma unroll
                for (int b = 0; b < 2; ++b)
#pragma unroll
                    for (int m = 0; m < 4; ++m)
#pragma unroll
                        for (int n = 0; n < 2; ++n) acc[a][b][m][n] = (f32x4){0.f, 0.f, 0.f, 0.f};
        }
        cur = nxt; cA = nA; cB = nB; ++ui;
        if (wr == 1) PG8_BAR;
    }
    PG8_WAIT_V(0);
    PG8_BAR;
#undef PG8_SA
#undef PG8_SB
#undef PG8_STAGE
#undef PG8_LDA
#undef PG8_LDB
#undef PG8_MMA
#undef PG8_WAIT_V
#undef PG8_WAIT_L
#undef PG8_BAR
#undef PG8_SCHED
}

typedef f32x4 (&AccRef)[2][2][4][2];
#define EPI_LOOP_AM _Pragma("unroll") for (int ai = 0; ai < 2; ++ai) _Pragma("unroll") for (int m = 0; m < 4; ++m)
struct EpiInprojM {
    static constexpr bool PERM = true;
    bf16_t *Ag, *gu, *gv, *q, *gates; const float* b_gate;
    __device__ __forceinline__ bool operator()(AccRef acc, const Unit& u, int wr, int wc, int fr, int fq) const {
        const int row0 = u.pm * BM + wr * 64 + fr, cl = wc * 32 + 8 * fq, pn = u.pn;
        if (pn < 2) {
            EPI_LOOP_AM { const int row = row0 + ai * HALF + m * 16;
#pragma unroll
                for (int bj = 0; bj < 2; ++bj) { const int c = pn * 256 + bj * HALF + cl, g = c >> 4, hp = c & 15;
                    *(u32x4*)(Ag + ((size_t)(g * NCH + (row >> 4)) * KE + (row & 15) * 16 + hp)) = pack8(acc[ai][bj][m][0], acc[ai][bj][m][1]); } }
        } else if (pn < 6) {
            bf16_t* base = (pn < 4 ? gu : gv) + (pn & 1) * 256 + cl;
            EPI_LOOP_AM { const int row = row0 + ai * HALF + m * 16;
#pragma unroll
                for (int bj = 0; bj < 2; ++bj) *(u32x4*)(base + (size_t)row * 512 + bj * HALF) = pack8(gelu4(acc[ai][bj][m][0]), gelu4(acc[ai][bj][m][1])); }
        } else if (pn < 8) {
            bf16_t* base = q + (pn & 1) * 256 + cl;
            EPI_LOOP_AM { const int row = row0 + ai * HALF + m * 16;
#pragma unroll
                for (int bj = 0; bj < 2; ++bj) *(u32x4*)(base + (size_t)row * 512 + bj * HALF) = pack8(acc[ai][bj][m][0] * 0.08838834764831845f, acc[ai][bj][m][1] * 0.08838834764831845f); }
        } else {
            const int cg = (pn - 8) * 256 + cl;
            f32x4 bv[2][2];
#pragma unroll
            for (int bj = 0; bj < 2; ++bj) { bv[bj][0] = *(const f32x4*)(b_gate + cg + bj * HALF); bv[bj][1] = *(const f32x4*)(b_gate + cg + bj * HALF + 4); }
            EPI_LOOP_AM { const int row = row0 + ai * HALF + m * 16;
#pragma unroll
                for (int bj = 0; bj < 2; ++bj) *(u32x4*)(gates + (size_t)row * 3072 + cg + bj * HALF) = pack8(sigm4(acc[ai][bj][m][0] + bv[bj][0]), sigm4(acc[ai][bj][m][1] + bv[bj][1])); }
        }
        return true;
    }
};
struct EpiKVM {
    static constexpr bool PERM = true;
    bf16_t *kb, *vT;
    __device__ __forceinline__ bool operator()(AccRef acc, const Unit& u, int wr, int wc, int fr, int fq) const {
        const int row0 = u.pm * BM + wr * 64 + fr, cl = wc * 32 + 8 * fq, pn = u.pn;
        if (pn < 2) {
            EPI_LOOP_AM { const int row = row0 + ai * HALF + m * 16;
#pragma unroll
                for (int bj = 0; bj < 2; ++bj) *(u32x4*)(kb + (size_t)row * 512 + pn * 256 + bj * HALF + cl) = pack8(acc[ai][bj][m][0], acc[ai][bj][m][1]); }
        } else {
            EPI_LOOP_AM { const int row = row0 + ai * HALF + m * 16, b = row >> 8, mm = row & 255;
#pragma unroll
                for (int bj = 0; bj < 2; ++bj) { const int hd = (pn - 2) * 256 + bj * HALF + cl; bf16_t* dst = vT + ((size_t)b * 512 + hd) * 256 + mm;
#pragma unroll
                    for (int n = 0; n < 2; ++n)
#pragma unroll
                        for (int j = 0; j < 4; ++j) dst[(size_t)(n * 4 + j) * 256] = (bf16_t)(cvtpk(acc[ai][bj][m][n][j], 0.f) & 0xffffu); } }
        }
        return true;
    }
};
struct EpiS5YM {
    static constexpr bool PERM = true;
    bf16_t* yap;
    __device__ __forceinline__ bool operator()(AccRef acc, const Unit& u, int wr, int wc, int fr, int fq) const {
        const int g = u.pm >> 2, mch0 = (u.pm & 3) * BM + wr * 64 + fr, cl = wc * 32 + 8 * fq;
        EPI_LOOP_AM { const int mch = mch0 + ai * HALF + m * 16;
#pragma unroll
            for (int bj = 0; bj < 2; ++bj) { const int n = bj * HALF + cl, tau = n >> 4, hh = n & 15; const size_t tg = (size_t)mch * 16 + tau;
                *(u32x4*)(yap + tg * 512 + g * 16 + hh) = pack8(gelu4(acc[ai][bj][m][0]), gelu4(acc[ai][bj][m][1])); } }
        return true;
    }
};
struct EpiGluM {
    static constexpr bool PERM = true;
    const bf16_t* yap; const float* b_glu; bf16_t* yag;
    __device__ __forceinline__ bool operator()(AccRef acc, const Unit& u, int wr, int wc, int fr, int fq) const {
        const int row0 = u.pm * BM + wr * 64 + fr, c0 = u.pn * 256 + wc * 32 + 8 * fq;
        f32x4 bv[2][2];
#pragma unroll
        for (int bj = 0; bj < 2; ++bj) { bv[bj][0] = *(const f32x4*)(b_glu + c0 + bj * HALF); bv[bj][1] = *(const f32x4*)(b_glu + c0 + bj * HALF + 4); }
        EPI_LOOP_AM { const size_t ro = (size_t)(row0 + ai * HALF + m * 16) * 512 + c0;
#pragma unroll
            for (int bj = 0; bj < 2; ++bj) { const u32x4 yv = *(const u32x4*)(yap + ro + bj * HALF);
                *(u32x4*)(yag + ro + bj * HALF) = pack8(unpk_lo(yv) * sigm4(acc[ai][bj][m][0] + bv[bj][0]), unpk_hi(yv) * sigm4(acc[ai][bj][m][1] + bv[bj][1])); } }
        return true;
    }
};
struct EpiMergeM {
    static constexpr bool PERM = true;
    const bf16_t* gates; bf16_t* merged;
    __device__ __forceinline__ bool operator()(AccRef acc, const Unit& u, int wr, int wc, int fr, int fq) const {
        const int row0 = u.pm * BM + wr * 64 + fr, c0 = u.pn * 256 + wc * 32 + 8 * fq, sub = u.sub;
        EPI_LOOP_AM { const int row = row0 + ai * HALF + m * 16; const bf16_t* gr = gates + (size_t)row * 3072 + c0;
#pragma unroll
            for (int bj = 0; bj < 2; ++bj) {
                if (sub < 2) { const u32x4 nu = *(const u32x4*)(gr + sub * 1024 + bj * HALF), de = *(const u32x4*)(gr + (sub + 1) * 1024 + bj * HALF);
                    acc[ai][bj][m][0] = acc[ai][bj][m][0] * (unpk_lo(nu) * rcp4(unpk_lo(de))); acc[ai][bj][m][1] = acc[ai][bj][m][1] * (unpk_hi(nu) * rcp4(unpk_hi(de))); }
                else { const u32x4 g2 = *(const u32x4*)(gr + 2048 + bj * HALF);
                    *(u32x4*)(merged + (size_t)row * D + c0 + bj * HALF) = pack8(acc[ai][bj][m][0] * unpk_lo(g2), acc[ai][bj][m][1] * unpk_hi(g2)); } } }
        return sub == 2;
    }
};
struct EpiResM {
    static constexpr bool PERM = false;
    const float* base; float* out; bf16_t* ob; float* ss;
    __device__ __forceinline__ bool operator()(AccRef acc, const Unit& u, int wr, int wc, int fr, int fq) const {
        const int row0 = u.pm * BM + wr * 64 + fr, c0 = u.pn * 256 + wc * 32 + 4 * fq;
        EPI_LOOP_AM { const int row = row0 + ai * HALF + m * 16; const size_t ro = (size_t)row * D + c0; float s = 0.f;
#pragma unroll
            for (int bj = 0; bj < 2; ++bj)
#pragma unroll
                for (int n = 0; n < 2; ++n) { const f32x4 v = *(const f32x4*)(base + ro + bj * HALF + n * 16) + acc[ai][bj][m][n];
                    *(f32x4*)(out + ro + bj * HALF + n * 16) = v; s += (v[0] * v[0] + v[1] * v[1]) + (v[2] * v[2] + v[3] * v[3]);
                    if (ob) { u32x2 w; w.x = cvtpk(v[0], v[1]); w.y = cvtpk(v[2], v[3]); *(u32x2*)(ob + ro + bj * HALF + n * 16) = w; } }
            s += __shfl_xor(s, 16); s += __shfl_xor(s, 32);
            if (fq == 0) __hip_atomic_fetch_add(ss + row, s, __ATOMIC_RELAXED, __HIP_MEMORY_SCOPE_AGENT); }
        return true;
    }
};
struct EpiFfnUpM {
    static constexpr bool PERM = true;
    const float* ss1; bf16_t* act;
    __device__ __forceinline__ bool operator()(AccRef acc, const Unit& u, int wr, int wc, int fr, int fq) const {
        const int row0 = u.pm * BM + wr * 64 + fr, c0 = u.pn * 128 + wc * 32 + 8 * fq;
        EPI_LOOP_AM { const int row = row0 + ai * HALF + m * 16; const float rs = rsqrtf(ss1[row] * (1.f / D) + EPS);
            f32x4 o[2];
#pragma unroll
            for (int n = 0; n < 2; ++n) { const f32x4 gg = acc[ai][0][m][n] * rs, uu = acc[ai][1][m][n] * rs; o[n] = gg * sigm4(gg) * uu; }
            *(u32x4*)(act + (size_t)row * DFF + c0) = pack8(o[0], o[1]); }
        return true;
    }
};

struct MergeOrder { TileOrder T; const char *a0, *b0; long da1, da2, db1, db2; size_t ta, tb;
    __device__ __forceinline__ bool next(int i, Unit& u) const { const int j = i / 3, s = i - 3 * j; if (!T.tile((long)j * T.G + T.c, u.pm, u.pn)) return false;
        const long s1 = (s == 1) ? 1 : 0, s2 = (s == 2) ? 1 : 0;
        u.a = a0 + s1 * da1 + s2 * da2 + (size_t)u.pm * ta; u.b = b0 + s1 * db1 + s2 * db2 + (size_t)u.pn * tb; u.sub = s; return true; } };
struct S5YOrder { int G, c; const char* Ag; const char* Km;
    __device__ __forceinline__ bool next(int i, Unit& u) const { const int L = i * G + c; if (L >= 128) return false; const int g = L >> 2, rt = L & 3;
        u.a = Ag + ((size_t)g * NCH + 256 * rt) * KE * 2; u.b = Km + (size_t)g * 256 * KE * 2; u.pm = L; u.pn = 0; u.sub = 0; return true; } };
struct KvOrder { int G, c; const char* A; const char* B;
    __device__ __forceinline__ bool next(int i, Unit& u) const { const int first = G >= 32 ? G - 32 : 0, str = G >= 32 ? 32 : G; if (c < first) return false; const int L = i * str + (c - first); if (L >= 32) return false;
        u.pm = L >> 2; u.pn = L & 3; u.a = A + (size_t)u.pm * BM * D * 2; u.b = B + (size_t)u.pn * BM * D * 2; u.sub = 0; return true; } };

__device__ __forceinline__ void p0_transpose_item(const float* __restrict__ W, int K, int N, bf16_t* __restrict__ WT, int ldt, const float* __restrict__ scale, int mode, LAS float* scr, int item, int lane) {
    const int nblk = N / 32, kb = item / nblk, nb = item % nblk, k0 = 64 * kb, n0 = 32 * nb;
#pragma unroll 8
    for (int i = 0; i < 32; ++i) { const int kk = 2 * i + (lane >> 5); float v = W[(size_t)(k0 + kk) * N + n0 + (lane & 31)]; if (scale) v *= scale[k0 + kk]; scr[kk * 33 + (lane & 31)] = v; }
    LDS_WAIT(); asm volatile("" ::: "memory");
    const int c = lane & 7;
#pragma unroll
    for (int j = 0; j < 4; ++j) { const int n = (lane >> 3) + 8 * j; const LAS float* s = scr + (8 * c) * 33 + n;
        u32x4 o; o.x = cvtpk(s[0 * 33], s[1 * 33]); o.y = cvtpk(s[2 * 33], s[3 * 33]); o.z = cvtpk(s[4 * 33], s[5 * 33]); o.w = cvtpk(s[6 * 33], s[7 * 33]);
        const int ng = n0 + n, drow = mode == 0 ? ng : 256 * (ng >> 7) + 128 * (mode - 1) + (ng & 127);
        *(u32x4*)(WT + (size_t)drow * ldt + k0 + 8 * c) = o; }
    LDS_WAIT(); asm volatile("" ::: "memory");
}
__device__ __forceinline__ void rms_row_bf16(const float* __restrict__ xrow, const float* __restrict__ g, bf16_t* __restrict__ orow, int lane) {
    const f32x4* xr = (const f32x4*)xrow + lane; f32x4 v[4]; float s = 0.f;
#pragma unroll
    for (int j = 0; j < 4; ++j) { v[j] = xr[64 * j]; s += (v[j][0] * v[j][0] + v[j][1] * v[j][1]) + (v[j][2] * v[j][2] + v[j][3] * v[j][3]); }
    const float rs = rsqrtf(wave_sum(s) * (1.f / D) + EPS);
#pragma unroll
    for (int j = 0; j < 4; ++j) { const f32x4 gg = ((const f32x4*)g)[64 * j + lane]; const f32x4 o = v[j] * rs * gg; u32x2 w; w.x = cvtpk(o[0], o[1]); w.y = cvtpk(o[2], o[3]); ((u32x2*)orow)[64 * j + lane] = w; }
}

struct MArgs { const float* in[30]; float* out; unsigned char* ws; int mask, bars; };

__device__ __forceinline__ void prep_phase(const MArgs& a, LAS unsigned char* lds, int G, int bx, int tid, int wave, int lane) {
    unsigned char* ws = a.ws;
    for (int blk = bx; blk < 256; blk += G) {
        const int g = blk >> 3, j = blk & 7;
        LAS float* E = (LAS float*)lds; LAS float* Bb = (LAS float*)(lds + 8704); LAS float* Kt = (LAS float*)(lds + 16896);
        if (tid < 64) {
            const int idx = g * 64 + tid;
            const double dt = (double)expf(a.in[7][g]), ar = a.in[5][idx], ai = a.in[6][idx];
            const double xm = ar * dt;
            double mag = 1.0; { double term = 1.0; for (int i = 1; i <= 12; ++i) { term *= xm / (double)i; mag += term; } }
            const double th = ai * dt, kq = __builtin_rint(th * 0.6366197723675814);
            const double r = __builtin_fma(-kq, 6.123233995736766e-17, __builtin_fma(-kq, 1.5707963267948966, th)), r2 = r * r;
            const double sr = r * (1.0 + r2 * (-1.0 / 6 + r2 * (1.0 / 120 + r2 * (-1.0 / 5040 + r2 * (1.0 / 362880 + r2 * (-1.0 / 39916800 + r2 * (1.0 / 6227020800.0)))))));
            const double cr = 1.0 + r2 * (-0.5 + r2 * (1.0 / 24 + r2 * (-1.0 / 720 + r2 * (1.0 / 40320 + r2 * (-1.0 / 3628800 + r2 * (1.0 / 479001600 + r2 * (-1.0 / 87178291200.0)))))));
            const int qd = ((int)kq) & 3;
            const double cs = (qd == 0) ? cr : (qd == 1) ? -sr : (qd == 2) ? -cr : sr, sn = (qd == 0) ? sr : (qd == 1) ? cr : (qd == 2) ? -sr : -cr;
            const double abr = mag * cs, abi = mag * sn;
            const double nr = abr - 1.0, den = ar * ar + ai * ai, fre = (nr * ar + abi * ai) / den, fim = (abi * ar - nr * ai) / den;
            double er = 1.0, ei = 0.0;
#pragma unroll 1
            for (int t = 0; t <= LC; ++t) { E[(tid * 17 + t) * 2] = (float)er; E[(tid * 17 + t) * 2 + 1] = (float)ei; const double n1 = er * abr - ei * abi, n2 = er * abi + ei * abr; er = n1; ei = n2; }
#pragma unroll 1
            for (int h = 0; h < 16; ++h) { const double br = a.in[8][idx * 16 + h], bi = a.in[9][idx * 16 + h]; Bb[(tid * 16 + h) * 2] = (float)(fre * br - fim * bi); Bb[(tid * 16 + h) * 2 + 1] = (float)(fre * bi + fim * br); }
        }
        __syncthreads();
        const float* cmr = a.in[10] + (size_t)g * 16 * 64; const float* cmi = a.in[11] + (size_t)g * 16 * 64;
#pragma unroll 1
        for (int i = 0; i < 8; ++i) {
            const int e = tid + 512 * i, tau = e >> 8, h = (e >> 4) & 15, hp = e & 15; float s = 0.f;
#pragma unroll 4
            for (int p = 0; p < 64; ++p) { const float er = E[(p * 17 + tau) * 2], ei = E[(p * 17 + tau) * 2 + 1], br = Bb[(p * 16 + hp) * 2], bi = Bb[(p * 16 + hp) * 2 + 1];
                s += cmr[h * 64 + p] * (er * br - ei * bi) - cmi[h * 64 + p] * (er * bi + ei * br); }
            if (tau == 0 && hp == h) s += a.in[12][g * 16 + h];
            Kt[e] = s;
        }
        __syncthreads();
        bf16_t* Km = (bf16_t*)(ws + WS_KMAT) + (size_t)g * 256 * KE; bf16_t* We = (bf16_t*)(ws + WS_WEND) + (size_t)g * 128 * 256;
#pragma unroll 1
        for (int i = 0; i < 24; ++i) {
            const int idx = tid + 512 * i, nl = idx / KE, k = idx - nl * KE, n = 32 * j + nl, to = n >> 4, h = n & 15; float val = 0.f;
            if (k < 256) { const int ti = k >> 4, hp = k & 15; if (ti <= to) val = Kt[(to - ti) * 256 + h * 16 + hp]; }
            else { const int pp = k - 256, p = pp & 63, im = pp >> 6; const float cr = cmr[h * 64 + p], ci = cmi[h * 64 + p], er = E[(p * 17 + to + 1) * 2], ei = E[(p * 17 + to + 1) * 2 + 1];
                val = im ? -(cr * ei + ci * er) : (cr * er - ci * ei); }
            Km[(size_t)n * KE + k] = f2bf(val);
        }
#pragma unroll 1
        for (int i = 0; i < 8; ++i) {
            const int idx = tid + 512 * i, ppl = idx >> 8, k = idx & 255, pp = 16 * j + ppl, p = pp & 63, im = pp >> 6, tau = k >> 4, hp = k & 15;
            const float er = E[(p * 17 + (LC - 1 - tau)) * 2], ei = E[(p * 17 + (LC - 1 - tau)) * 2 + 1], br = Bb[(p * 16 + hp) * 2], bi = Bb[(p * 16 + hp) * 2 + 1];
            We[(size_t)pp * 256 + k] = f2bf(im ? (er * bi + ei * br) : (er * br - ei * bi));
        }
        if (j == 0 && tid < 64) { float* a16 = (float*)(ws + WS_TABE) + (size_t)(g * 64 + tid) * 2; a16[0] = E[(tid * 17 + LC) * 2]; a16[1] = E[(tid * 17 + LC) * 2 + 1]; }
        __syncthreads();
    }
    LAS float* scr = (LAS float*)(lds + wave * 16384);
    const int gw = bx * NWAVES + wave, NGW = G * NWAVES;
    constexpr int I_IN = (D / 64) * (INW / 32), I_G = (D / 64) * (DFF / 32), I_D = (DFF / 64) * (D / 32), I_KV = (D / 64) * (1024 / 32), I_O = I_KV, I_ABC = (512 / 64) * (D / 32), I_GLU = (512 / 64) * (512 / 32);
    constexpr int NITEMS = I_IN + 2 * I_G + I_D + I_KV + I_O + 3 * I_ABC + I_GLU;
#pragma unroll 1
    for (int it = gw; it < NITEMS; it += NGW) {
        int r = it;
        if (r < I_IN) { p0_transpose_item(a.in[3], D, INW, (bf16_t*)(ws + WS_WIN), D, nullptr, 0, scr, r, lane); continue; } r -= I_IN;
        if (r < I_G) { p0_transpose_item(a.in[26], D, DFF, (bf16_t*)(ws + WS_WGU), D, a.in[25], 1, scr, r, lane); continue; } r -= I_G;
        if (r < I_G) { p0_transpose_item(a.in[27], D, DFF, (bf16_t*)(ws + WS_WGU), D, a.in[25], 2, scr, r, lane); continue; } r -= I_G;
        if (r < I_D) { p0_transpose_item(a.in[28], DFF, D, (bf16_t*)(ws + WS_WD), DFF, nullptr, 0, scr, r, lane); continue; } r -= I_D;
        if (r < I_KV) { p0_transpose_item(a.in[20], D, 1024, (bf16_t*)(ws + WS_WKV), D, nullptr, 0, scr, r, lane); continue; } r -= I_KV;
        if (r < I_O) { p0_transpose_item(a.in[24], D, D, (bf16_t*)(ws + WS_WOUT), D, nullptr, 0, scr, r, lane); continue; } r -= I_O;
        if (r < I_ABC) { p0_transpose_item(a.in[21], 512, D, (bf16_t*)(ws + WS_WA), 512, nullptr, 0, scr, r, lane); continue; } r -= I_ABC;
        if (r < I_ABC) { p0_transpose_item(a.in[22], 512, D, (bf16_t*)(ws + WS_WB), 512, nullptr, 0, scr, r, lane); continue; } r -= I_ABC;
        if (r < I_ABC) { p0_transpose_item(a.in[23], 512, D, (bf16_t*)(ws + WS_WC), 512, nullptr, 0, scr, r, lane); continue; } r -= I_ABC;
        p0_transpose_item(a.in[13], 512, 512, (bf16_t*)(ws + WS_WGLU), 512, nullptr, 0, scr, r, lane);
    }
#pragma unroll 1
    for (int r = gw; r < T + TM; r += NGW) {
        if (r < T) rms_row_bf16(a.in[0] + (size_t)r * D, a.in[2], (bf16_t*)(ws + WS_R1) + (size_t)r * D, lane);
        else rms_row_bf16(a.in[1] + (size_t)(r - T) * D, a.in[19], (bf16_t*)(ws + WS_MEMN) + (size_t)(r - T) * D, lane);
    }
    { bf16_t* Wm = (bf16_t*)(ws + WS_WM); const float* w_s = a.in[17];
      for (int e = bx * NTHREADS + tid; e < SGG * SGB * SGB; e += G * NTHREADS) { const int t = (e >> 7) & 127, s = e & 127; Wm[e] = (s <= t) ? f2bf(w_s[e]) : (bf16_t)0; } }
}

#ifndef PH_EN
#define PH_EN W_ALL
#endif
__global__ void __launch_bounds__(NTHREADS, 2) mega_fwd(MArgs a) {
    extern __shared__ __attribute__((aligned(16))) unsigned char lds_raw[];
    LAS unsigned char* lds = (LAS unsigned char*)lds_raw;
    const int tid = threadIdx.x, lane = tid & 63, wave = __builtin_amdgcn_readfirstlane(tid >> 6);
    const int G = gridDim.x, bx = blockIdx.x, mask = a.mask;
    unsigned char* ws = a.ws;
    for (int u = tid; u < (LDS_BYTES - LDSCTL_OFF) / 4; u += NTHREADS) ((LAS unsigned*)(lds + LDSCTL_OFF))[u] = 0u;
    __syncthreads();
    XcdBarrier bar; bar.bar = (unsigned*)(ws + WS_CTL) + CW_BAR; bar.x = 0; bar.st = nullptr;
    if (a.bars) bar = xcd_barrier_post((unsigned*)(ws + WS_CTL) + CW_BAR, (volatile LAS unsigned*)(lds + LDSCTL_OFF) + 8);
#define GRID_BAR(k) do { if (a.bars & (1 << (k))) xcd_barrier(bar); } while (0)
#define P_BF(off) ((bf16_t*)(ws + (off)))
#define WinT P_BF(WS_WIN)
#define WguT P_BF(WS_WGU)
#define WdT P_BF(WS_WD)
#define WkvT P_BF(WS_WKV)
#define WoutT P_BF(WS_WOUT)
#define WaT P_BF(WS_WA)
#define WbT P_BF(WS_WB)
#define WcT P_BF(WS_WC)
#define WgluT P_BF(WS_WGLU)
#define KmatT P_BF(WS_KMAT)
#define memn P_BF(WS_MEMN)
#define kb P_BF(WS_KB)
#define vT P_BF(WS_VT)
#define h P_BF(WS_R1)
#define yap P_BF(WS_R1)
#define merged P_BF(WS_R1)
#define Ag P_BF(WS_R2)
#define yag P_BF(WS_R2)
#define x1b P_BF(WS_R2)
#define ob P_BF(WS_R6)
#define gates P_BF(WS_R7)
#define act P_BF(WS_R7)
#define q ((bf16_t*)((unsigned char*)a.out))
#define gu ((bf16_t*)((unsigned char*)a.out + 16 * MiB))
#define gv ((bf16_t*)((unsigned char*)a.out + 32 * MiB))
#define sgu ((bf16_t*)((unsigned char*)a.out + 48 * MiB))
#define ss1 ((float*)(ws + WS_CTL + CTL_SS1))
#define ss2 ((float*)(ws + WS_CTL + CTL_SS2))
    if ((PH_EN & W_PREP) && (mask & W_PREP)) prep_phase(a, lds, G, bx, tid, wave, lane);
    GRID_BAR(0);
    if ((PH_EN & W_INPROJ) && (mask & W_INPROJ)) { TileOrder S; S.init(T, INW, G, bx, h, D, WinT, D); EpiInprojM E{Ag, gu, gv, q, gates, a.in[4]}; gemm_phase(lds, D, D, D / BK, S, E); }
    GRID_BAR(1);
    if ((PH_EN & W_KV) && (mask & W_KV)) { KvOrder S{G, bx, (const char*)memn, (const char*)WkvT}; EpiKVM E{kb, vT}; gemm_phase(lds, D, D, D / BK, S, E); }
    GRID_BAR(2);
    if ((PH_EN & W_S5Y) && (mask & W_S5Y)) { S5YOrder S{G, bx, (const char*)Ag, (const char*)KmatT}; EpiS5YM E{yap}; gemm_phase(lds, KE, KE, KE / BK, S, E); }
    GRID_BAR(3);
    if ((PH_EN & W_GLU) && (mask & W_GLU)) { TileOrder S; S.init(T, 512, G, bx, yap, 512, WgluT, 512); EpiGluM E{yap, a.in[14], yag}; gemm_phase(lds, 512, 512, 512 / BK, S, E); }
    GRID_BAR(4);
    if ((PH_EN & W_MERGE) && (mask & W_MERGE)) { MergeOrder S; S.T.init(T, D, G, bx, nullptr, 512, nullptr, 512); S.a0 = (const char*)yag; S.da1 = (const char*)sgu - (const char*)yag; S.da2 = (const char*)ob - (const char*)yag;
        S.b0 = (const char*)WaT; S.db1 = (const char*)WbT - (const char*)WaT; S.db2 = (const char*)WcT - (const char*)WaT; S.ta = (size_t)BM * 512 * 2; S.tb = (size_t)BM * 512 * 2;
        EpiMergeM E{gates, merged}; gemm_phase(lds, 512, 512, 512 / BK, S, E); }
    GRID_BAR(5);
    if ((PH_EN & W_WOUT) && (mask & W_WOUT)) { TileOrder S; S.init(T, D, G, bx, merged, D, WoutT, D); EpiResM E{a.in[0], a.out, x1b, ss1}; gemm_phase(lds, D, D, D / BK, S, E); }
    GRID_BAR(6);
    if ((PH_EN & W_FFNUP) && (mask & W_FFNUP)) { TileOrder S; S.init(T, NGU, G, bx, x1b, D, WguT, D); EpiFfnUpM E{ss1, act}; gemm_phase(lds, D, D, D / BK, S, E); }
    GRID_BAR(7);
    if ((PH_EN & W_FFNDOWN) && (mask & W_FFNDOWN)) { TileOrder S; S.init(T, D, G, bx, act, DFF, WdT, DFF); EpiResM E{a.out, a.out, nullptr, ss2}; gemm_phase(lds, DFF, DFF, DFF / BK, S, E); }
    GRID_BAR(8);
    if ((PH_EN & W_FINAL) && (mask & W_FINAL)) {
        const int gw = bx * NWAVES + wave, NGW = G * NWAVES; const float* gf = a.in[29];
        for (int r = gw; r < T; r += NGW) { f32x4* xr = (f32x4*)(a.out + (size_t)r * D) + lane; const float rs = rsqrtf(ss2[r] * (1.f / D) + EPS);
#pragma unroll
            for (int j = 0; j < 4; ++j) { const f32x4 gg = ((const f32x4*)gf)[64 * j + lane]; xr[64 * j] = xr[64 * j] * rs * gg; } }
    }
#undef GRID_BAR
#undef WinT
#undef WguT
#undef WdT
#undef WkvT
#undef WoutT
#undef WaT
#undef WbT
#undef WcT
#undef WgluT
#undef KmatT
#undef memn
#undef kb
#undef vT
#undef h
#undef yap
#undef merged
#undef Ag
#undef yag
#undef x1b
#undef ob
#undef gates
#undef act
#undef q
#undef gu
#undef gv
#undef sgu
#undef ss1
#undef ss2
}

#ifndef MEGA_STAGES
#define MEGA_STAGES 0
#endif
#ifndef ONE_LAUNCH
#define ONE_LAUNCH 0
#endif
extern "C" void kernel_launch(void* const* d_in, const int* in_sizes, int n_in, void* d_out, int out_size, void* d_ws, size_t ws_size, hipStream_t stream) {
    static int grid = 0;
    if (grid == 0) {
        if (n_in != 30 || out_size != T * D || ws_size < WS_END) { fprintf(stderr, "kernel_launch: unexpected sizes n_in %d out %d ws %zu\n", n_in, out_size, ws_size); grid = -1; return; }
        int dev = 0, cus = 0, per_cu = 0;
        if (hipGetDevice(&dev) != hipSuccess || hipDeviceGetAttribute(&cus, hipDeviceAttributeMultiprocessorCount, dev) != hipSuccess) { grid = -1; return; }
        if (hipFuncSetAttribute((const void*)mega_fwd, hipFuncAttributeMaxDynamicSharedMemorySize, LDS_BYTES) != hipSuccess) { fprintf(stderr, "kernel_launch: hipFuncSetAttribute failed\n"); grid = -1; return; }
        if (hipOccupancyMaxActiveBlocksPerMultiprocessor(&per_cu, (const void*)mega_fwd, NTHREADS, LDS_BYTES) != hipSuccess || per_cu < 1) { fprintf(stderr, "kernel_launch: occupancy query says %d blocks/CU\n", per_cu); (void)hipGetLastError(); }
        grid = cus;
    }
    if (grid < 0) return;
    const float* x = (const float*)d_in[0]; const float* mem = (const float*)d_in[1]; const float* g_mix = (const float*)d_in[2]; const float* w_in = (const float*)d_in[3];
    const float* b_gate = (const float*)d_in[4]; const float* a_re = (const float*)d_in[5]; const float* a_im = (const float*)d_in[6]; const float* log_dt = (const float*)d_in[7];
    const float* bm_re = (const float*)d_in[8]; const float* bm_im = (const float*)d_in[9]; const float* cm_re = (const float*)d_in[10]; const float* cm_im = (const float*)d_in[11];
    const float* d_skip = (const float*)d_in[12]; const float* w_glu = (const float*)d_in[13]; const float* b_glu = (const float*)d_in[14]; const float* g_sgu = (const float*)d_in[15];
    const float* beta_sgu = (const float*)d_in[16]; const float* w_s = (const float*)d_in[17]; const float* b_s = (const float*)d_in[18]; const float* g_mem = (const float*)d_in[19];
    const float* w_kv = (const float*)d_in[20]; const float* w_a = (const float*)d_in[21]; const float* w_b = (const float*)d_in[22]; const float* w_c = (const float*)d_in[23];
    const float* w_out = (const float*)d_in[24]; const float* g_ffn = (const float*)d_in[25]; const float* w_gate = (const float*)d_in[26]; const float* w_up = (const float*)d_in[27];
    const float* w_down = (const float*)d_in[28]; const float* g_final = (const float*)d_in[29];
    unsigned char* ws = (unsigned char*)d_ws; float* out = (float*)d_out;
    bf16_t* WinT = (bf16_t*)(ws + WS_WIN); bf16_t* WguT = (bf16_t*)(ws + WS_WGU); bf16_t* WdT = (bf16_t*)(ws + WS_WD); bf16_t* WkvT = (bf16_t*)(ws + WS_WKV); bf16_t* WoutT = (bf16_t*)(ws + WS_WOUT);
    bf16_t* WaT = (bf16_t*)(ws + WS_WA); bf16_t* WbT = (bf16_t*)(ws + WS_WB); bf16_t* WcT = (bf16_t*)(ws + WS_WC); bf16_t* WgluT = (bf16_t*)(ws + WS_WGLU);
    bf16_t* KmatT = (bf16_t*)(ws + WS_KMAT); bf16_t* WendT = (bf16_t*)(ws + WS_WEND); bf16_t* Wm = (bf16_t*)(ws + WS_WM); float* tabE = (float*)(ws + WS_TABE); float* tabB = (float*)(ws + WS_TABB);
    float* sgst = (float*)(ws + WS_SGST); bf16_t* memn = (bf16_t*)(ws + WS_MEMN); bf16_t* kb = (bf16_t*)(ws + WS_KB); bf16_t* vT = (bf16_t*)(ws + WS_VT);
    bf16_t* h = (bf16_t*)(ws + WS_R1); bf16_t* yap = (bf16_t*)(ws + WS_R1); bf16_t* merged = (bf16_t*)(ws + WS_R1);
    bf16_t* Ag = (bf16_t*)(ws + WS_R2); bf16_t* yag = (bf16_t*)(ws + WS_R2); bf16_t* x1b = (bf16_t*)(ws + WS_R2); bf16_t* ob = (bf16_t*)(ws + WS_R6);
    bf16_t* gates = (bf16_t*)(ws + WS_R7); bf16_t* act = (bf16_t*)(ws + WS_R7);
    bf16_t* q = (bf16_t*)((unsigned char*)d_out); bf16_t* gu = (bf16_t*)((unsigned char*)d_out + 16 * MiB); bf16_t* gv = (bf16_t*)((unsigned char*)d_out + 32 * MiB); bf16_t* sgu = (bf16_t*)((unsigned char*)d_out + 48 * MiB);
    float* ss1 = (float*)(ws + WS_CTL + CTL_SS1); float* ss2 = (float*)(ws + WS_CTL + CTL_SS2);
    (void)tabE; (void)tabB; (void)KmatT; (void)WendT;

    MArgs ma{};
    for (int i = 0; i < 30; ++i) ma.in[i] = (const float*)d_in[i];
    ma.out = out; ma.ws = ws;
    (void)hipMemsetAsync(ws + WS_CTL, 0, 1 * MiB, stream);
#define MEGA(m, b) do { ma.mask = (m); ma.bars = (b); hipLaunchKernelGGL(mega_fwd, dim3(grid), dim3(NTHREADS), LDS_BYTES, stream, ma); } while (0)
#define ISM(w) ((MEGA_STAGES) & (w))
    if (ONE_LAUNCH) { MEGA(W_ALL, 0x1ff); return; }
    if (ISM(W_PREP)) MEGA(W_PREP, 0);
    else {
        k_tconv<<<dim3(INW / 64, D / 64), 512, 0, stream>>>(w_in, D, INW, WinT, D, nullptr, 0, 0);
        k_tconv<<<dim3(DFF / 64, D / 64), 512, 0, stream>>>(w_gate, D, DFF, WguT, D, g_ffn, 1, 0);
        k_tconv<<<dim3(DFF / 64, D / 64), 512, 0, stream>>>(w_up, D, DFF, WguT, D, g_ffn, 2, 0);
        k_tconv<<<dim3(D / 64, DFF / 64), 512, 0, stream>>>(w_down, DFF, D, WdT, DFF, nullptr, 0, 0);
        k_tconv<<<dim3(1024 / 64, D / 64), 512, 0, stream>>>(w_kv, D, 1024, WkvT, D, nullptr, 0, 0);
        k_tconv<<<dim3(D / 64, D / 64), 512, 0, stream>>>(w_out, D, D, WoutT, D, nullptr, 0, 0);
        k_tconv<<<dim3(D / 64, 512 / 64), 512, 0, stream>>>(w_a, 512, D, WaT, 512, nullptr, 0, 0);
        k_tconv<<<dim3(D / 64, 512 / 64), 512, 0, stream>>>(w_b, 512, D, WbT, 512, nullptr, 0, 0);
        k_tconv<<<dim3(D / 64, 512 / 64), 512, 0, stream>>>(w_c, 512, D, WcT, 512, nullptr, 0, 0);
        k_tconv<<<dim3(512 / 64, 512 / 64), 512, 0, stream>>>(w_glu, 512, 512, WgluT, 512, nullptr, 0, 0);
        k_rmsrows<<<T / 8, 512, 0, stream>>>(x, g_mix, h, T);
        k_rmsrows<<<TM / 8, 512, 0, stream>>>(mem, g_mem, memn, TM);
        k_s5tab<<<(S5G * S5P + 255) / 256, 256, 0, stream>>>(a_re, a_im, log_dt, bm_re, bm_im, tabE, tabB);
        k_s5mats<<<dim3((256 * KE + 128 * 256) / 256, S5G), 256, 0, stream>>>(tabE, tabB, cm_re, cm_im, d_skip, KmatT, WendT);
        k_wm<<<(SGG * SGB * SGB + 255) / 256, 256, 0, stream>>>(w_s, Wm);
    }
    if (ISM(W_INPROJ)) MEGA(W_INPROJ, 0); else k_ngemm<EpiInproj><<<dim3(INW / 64, T / 4), 256, 0, stream>>>(h, D, WinT, D, D, EpiInproj{Ag, gu, gv, q, gates, b_gate});
    if (ISM(W_KV)) MEGA(W_KV, 0); else k_ngemm<EpiKV><<<dim3(1024 / 64, TM / 4), 256, 0, stream>>>(memn, D, WkvT, D, D, EpiKV{kb, vT});
    if (ISM(W_S5L)) { MEGA(W_S5L, 0); MEGA(W_S5Y, 0); } else k_s5_naive<<<NB * S5G, 64, 0, stream>>>(Ag, a_re, a_im, log_dt, bm_re, bm_im, cm_re, cm_im, d_skip, yap);
    if (ISM(W_ATTN)) MEGA(W_ATTN, 0); else k_attn_naive<<<T * XH, 256, 0, stream>>>(q, kb, vT, ob);
    if (ISM(W_SGU)) MEGA(W_SGU, 0);
    else { k_sgu_stats<<<T / 8, 512, 0, stream>>>(gv, sgst); k_sgu_naive<<<dim3(2, T), 256, 0, stream>>>(gu, gv, sgst, Wm, b_s, g_sgu, beta_sgu, sgu); }
    if (ISM(W_GLU)) MEGA(W_GLU, 0); else k_ngemm<EpiGlu><<<dim3(512 / 64, T / 4), 256, 0, stream>>>(yap, 512, WgluT, 512, 512, EpiGlu{yap, b_glu, yag});
    if (ISM(W_MERGE)) MEGA(W_MERGE, 0); else k_merge_naive<<<dim3(D / 64, T / 4), 256, 0, stream>>>(yag, sgu, ob, WaT, WbT, WcT, gates, merged);
    if (ISM(W_WOUT)) MEGA(W_WOUT, 0);
    else { k_ngemm<EpiWout><<<dim3(D / 64, T / 4), 256, 0, stream>>>(merged, D, WoutT, D, D, EpiWout{x, out, x1b}); k_rowss<<<T / 8, 512, 0, stream>>>(out, ss1); }
    if (ISM(W_FFNUP)) MEGA(W_FFNUP, 0); else k_ffnup_naive<<<dim3(DFF / 64, T / 4), 256, 0, stream>>>(x1b, WguT, ss1, act);
    if (ISM(W_FFNDOWN)) MEGA(W_FFNDOWN, 0);
    else { k_ngemm<EpiDown><<<dim3(D / 64, T / 4), 256, 0, stream>>>(act, DFF, WdT, DFF, DFF, EpiDown{out}); k_rowss<<<T / 8, 512, 0, stream>>>(out, ss2); }
    if (ISM(W_FINAL)) MEGA(W_FINAL, 0); else k_final<<<T * D / 4 / 256, 256, 0, stream>>>(out, ss2, g_final);
}
```

```cpp
#define MEGA_STAGES (W_ALL)
#include <hip/hip_runtime.h>
#include <cstdio>
#include <cstdint>

typedef unsigned short bf16_t;
constexpr int NB = 8, SEQ = 2048, D = 1024, T = NB * SEQ, MEML = 256, TM = NB * MEML;
constexpr int S5W = 512, S5G = 32, S5H = 16, S5P = 64, LC = 16, NCH = T / LC, KE = LC * S5H + 2 * S5P;
constexpr int SGW = 512, SGG = 4, SGD = 128, SGB = 128;
constexpr int XH = 4, XD = 128, XW = 512;
constexpr int DFF = 2816, INW = 5120, NGU = 2 * DFF;
constexpr float EPS = 1e-6f;
constexpr size_t MiB = 1u << 20;
constexpr size_t WS_CTL = 0;
constexpr size_t CTL_SS1 = 256 * 1024, CTL_SS2 = 384 * 1024;
constexpr size_t WS_WIN = 1 * MiB, WS_WGU = 11 * MiB, WS_WD = 22 * MiB, WS_WKV = 28 * MiB, WS_WOUT = 30 * MiB;
constexpr size_t WS_WA = 32 * MiB, WS_WB = 33 * MiB, WS_WC = 34 * MiB, WS_WGLU = 35 * MiB, WS_KMAT = 36 * MiB, WS_WEND = 42 * MiB;
constexpr size_t WS_WM = 44 * MiB, WS_TABE = 44 * MiB + 256 * 1024, WS_TABB = 44 * MiB + 512 * 1024, WS_SGST = 45 * MiB;
constexpr size_t WS_MEMN = 46 * MiB, WS_KB = 50 * MiB, WS_VT = 52 * MiB;
constexpr size_t WS_R1 = 56 * MiB;
constexpr size_t WS_R2 = 88 * MiB;
constexpr size_t WS_R6 = 112 * MiB;
constexpr size_t WS_R7 = 128 * MiB;
constexpr size_t WS_END = 224 * MiB;

__device__ __forceinline__ float bf2f(bf16_t v) { return __uint_as_float((unsigned)v << 16); }
__device__ __forceinline__ bf16_t f2bf(float f) { unsigned u = __float_as_uint(f); return (bf16_t)((u + 0x7fffu + ((u >> 16) & 1u)) >> 16); }
__device__ __forceinline__ float gelu_t(float x) { const float u = 0.7978845608028654f * (x + 0.044715f * x * x * x); return 0.5f * x * (1.f + tanhf(u)); }
__device__ __forceinline__ float sigm(float x) { return 1.f / (1.f + expf(-x)); }
__device__ __forceinline__ float wave_sum(float v) {
#pragma unroll
    for (int o = 1; o < 64; o <<= 1) v += __shfl_xor(v, o);
    return v;
}
__device__ __forceinline__ float wave_max(float v) {
#pragma unroll
    for (int o = 1; o < 64; o <<= 1) v = fmaxf(v, __shfl_xor(v, o));
    return v;
}
__device__ __forceinline__ float dot8(uint4 a, uint4 b) {
    float s = 0.f;
    s += __uint_as_float(a.x << 16) * __uint_as_float(b.x << 16) + __uint_as_float(a.x & 0xffff0000u) * __uint_as_float(b.x & 0xffff0000u);
    s += __uint_as_float(a.y << 16) * __uint_as_float(b.y << 16) + __uint_as_float(a.y & 0xffff0000u) * __uint_as_float(b.y & 0xffff0000u);
    s += __uint_as_float(a.z << 16) * __uint_as_float(b.z << 16) + __uint_as_float(a.z & 0xffff0000u) * __uint_as_float(b.z & 0xffff0000u);
    s += __uint_as_float(a.w << 16) * __uint_as_float(b.w << 16) + __uint_as_float(a.w & 0xffff0000u) * __uint_as_float(b.w & 0xffff0000u);
    return s;
}
__device__ __forceinline__ float dotrow(const bf16_t* a, const bf16_t* b, int K) {
    float acc = 0.f;
    for (int k = 0; k < K; k += 8) acc += dot8(*(const uint4*)(a + k), *(const uint4*)(b + k));
    return acc;
}

__global__ void __launch_bounds__(512) k_tconv(const float* __restrict__ W, int K, int N, bf16_t* __restrict__ WT, int ldt, const float* __restrict__ scale, int mode, int row_off) {
    __shared__ float tile[64][65];
    const int n0 = blockIdx.x * 64, k0 = blockIdx.y * 64, tid = threadIdx.x;
#pragma unroll
    for (int i = 0; i < 8; ++i) { const int kk = i * 8 + (tid >> 6), nn = tid & 63; float v = W[(size_t)(k0 + kk) * N + n0 + nn]; if (scale) v *= scale[k0 + kk]; tile[kk][nn] = v; }
    __syncthreads();
    const int n = tid >> 3, kc = tid & 7, ng = n0 + n;
    int drow;
    if (mode == 0) drow = ng + row_off; else drow = 256 * (ng >> 7) + 128 * (mode - 1) + (ng & 127);
    uint4 o;
    o.x = (unsigned)f2bf(tile[kc * 8 + 0][n]) | ((unsigned)f2bf(tile[kc * 8 + 1][n]) << 16);
    o.y = (unsigned)f2bf(tile[kc * 8 + 2][n]) | ((unsigned)f2bf(tile[kc * 8 + 3][n]) << 16);
    o.z = (unsigned)f2bf(tile[kc * 8 + 4][n]) | ((unsigned)f2bf(tile[kc * 8 + 5][n]) << 16);
    o.w = (unsigned)f2bf(tile[kc * 8 + 6][n]) | ((unsigned)f2bf(tile[kc * 8 + 7][n]) << 16);
    *(uint4*)(WT + (size_t)drow * ldt + k0 + kc * 8) = o;
}
__global__ void __launch_bounds__(512) k_rmsrows(const float* __restrict__ x, const float* __restrict__ g, bf16_t* __restrict__ out, int rows) {
    const int row = blockIdx.x * 8 + (threadIdx.x >> 6), lane = threadIdx.x & 63;
    if (row >= rows) return;
    const float4* xr = (const float4*)(x + (size_t)row * D) + lane;
    float4 v[4]; float s = 0.f;
#pragma unroll
    for (int j = 0; j < 4; ++j) { v[j] = xr[64 * j]; s += v[j].x * v[j].x + v[j].y * v[j].y + v[j].z * v[j].z + v[j].w * v[j].w; }
    const float rs = rsqrtf(wave_sum(s) * (1.f / D) + EPS);
#pragma unroll
    for (int j = 0; j < 4; ++j) {
        const float4 gg = ((const float4*)g)[64 * j + lane];
        uint2 o; o.x = (unsigned)f2bf(v[j].x * rs * gg.x) | ((unsigned)f2bf(v[j].y * rs * gg.y) << 16); o.y = (unsigned)f2bf(v[j].z * rs * gg.z) | ((unsigned)f2bf(v[j].w * rs * gg.w) << 16);
        ((uint2*)(out + (size_t)row * D))[64 * j + lane] = o;
    }
}
__global__ void k_s5tab(const float* a_re, const float* a_im, const float* log_dt, const float* bm_re, const float* bm_im, float* tabE, float* tabB) {
    const int idx = blockIdx.x * blockDim.x + threadIdx.x; if (idx >= S5G * S5P) return;
    const int g = idx / S5P;
    const double dt = exp((double)log_dt[g]), ar = a_re[idx], ai = a_im[idx];
    const double mag = exp(ar * dt), th = ai * dt;
    const double abr = mag * cos(th), abi = mag * sin(th);
    const double nr = abr - 1.0, den = ar * ar + ai * ai;
    const double fre = (nr * ar + abi * ai) / den, fim = (abi * ar - nr * ai) / den;
    double er = 1.0, ei = 0.0;
    for (int t = 0; t <= LC; ++t) { tabE[(idx * 17 + t) * 2] = (float)er; tabE[(idx * 17 + t) * 2 + 1] = (float)ei; const double nr2 = er * abr - ei * abi, ni2 = er * abi + ei * abr; er = nr2; ei = ni2; }
    for (int h = 0; h < S5H; ++h) { const double br = bm_re[idx * S5H + h], bi = bm_im[idx * S5H + h]; tabB[(idx * 16 + h) * 2] = (float)(fre * br - fim * bi); tabB[(idx * 16 + h) * 2 + 1] = (float)(fre * bi + fim * br); }
}
__global__ void __launch_bounds__(256) k_s5mats(const float* __restrict__ tabE, const float* __restrict__ tabB, const float* __restrict__ cm_re, const float* __restrict__ cm_im, const float* __restrict__ d_skip, bf16_t* __restrict__ KmatT, bf16_t* __restrict__ WendT) {
    const int g = blockIdx.y;
    const int e = blockIdx.x * 256 + threadIdx.x;
    const float* E = tabE + (size_t)g * S5P * 17 * 2; const float* Bb = tabB + (size_t)g * S5P * 16 * 2;
    if (e < 256 * KE) {
        const int n = e / KE, k = e % KE, to = n >> 4, h = n & 15; float val = 0.f;
        if (k < 256) {
            const int ti = k >> 4, hp = k & 15;
            if (ti <= to) {
                const int tau = to - ti; float s = 0.f;
                for (int p = 0; p < S5P; ++p) {
                    const float cr = cm_re[(g * 16 + h) * 64 + p], ci = cm_im[(g * 16 + h) * 64 + p];
                    const float er = E[(p * 17 + tau) * 2], ei = E[(p * 17 + tau) * 2 + 1];
                    const float br = Bb[(p * 16 + hp) * 2], bi = Bb[(p * 16 + hp) * 2 + 1];
                    const float xr = er * br - ei * bi, xi = er * bi + ei * br;
                    s += cr * xr - ci * xi;
                }
                if (tau == 0 && hp == h) s += d_skip[g * 16 + h];
                val = s;
            }
        } else {
            const int pp = k - 256, p = pp & 63, im = pp >> 6;
            const float cr = cm_re[(g * 16 + h) * 64 + p], ci = cm_im[(g * 16 + h) * 64 + p];
            const float er = E[(p * 17 + to + 1) * 2], ei = E[(p * 17 + to + 1) * 2 + 1];
            val = im ? -(cr * ei + ci * er) : (cr * er - ci * ei);
        }
        KmatT[(size_t)g * 256 * KE + e] = f2bf(val);
    } else {
        const int e2 = e - 256 * KE; if (e2 >= 128 * 256) return;
        const int pp = e2 >> 8, k = e2 & 255, p = pp & 63, im = pp >> 6, tau = k >> 4, hp = k & 15;
        const float er = E[(p * 17 + (LC - 1 - tau)) * 2], ei = E[(p * 17 + (LC - 1 - tau)) * 2 + 1];
        const float br = Bb[(p * 16 + hp) * 2], bi = Bb[(p * 16 + hp) * 2 + 1];
        WendT[(size_t)g * 128 * 256 + e2] = f2bf(im ? (er * bi + ei * br) : (er * br - ei * bi));
    }
}
__global__ void k_wm(const float* __restrict__ w_s, bf16_t* __restrict__ Wm) {
    const int e = blockIdx.x * blockDim.x + threadIdx.x; if (e >= SGG * SGB * SGB) return;
    const int t = (e >> 7) & 127, s = e & 127; Wm[e] = (s <= t) ? f2bf(w_s[e]) : (bf16_t)0;
}

template <class Epi> __global__ void __launch_bounds__(256) k_ngemm(const bf16_t* __restrict__ A, int lda, const bf16_t* __restrict__ Bt, int ldb, int K, Epi e) {
    const int n = blockIdx.x * 64 + (threadIdx.x & 63), m = blockIdx.y * 4 + (threadIdx.x >> 6);
    e(m, n, dotrow(A + (size_t)m * lda, Bt + (size_t)n * ldb, K));
}
struct EpiInproj {
    bf16_t *Ag, *gu, *gv, *q, *gates; const float* b_gate;
    __device__ void operator()(int m, int n, float acc) const {
        if (n < 512) { const int g = n >> 4; Ag[((size_t)g * NCH + (m >> 4)) * KE + (m & 15) * 16 + (n & 15)] = f2bf(acc); }
        else if (n < 1024) gu[(size_t)m * 512 + n - 512] = f2bf(gelu_t(acc));
        else if (n < 1536) gv[(size_t)m * 512 + n - 1024] = f2bf(gelu_t(acc));
        else if (n < 2048) q[(size_t)m * 512 + n - 1536] = f2bf(acc * 0.08838834764831845f);
        else gates[(size_t)m * 3072 + n - 2048] = f2bf(sigm(acc + b_gate[n - 2048]));
    }
};
struct EpiKV {
    bf16_t *kb, *vT;
    __device__ void operator()(int m, int n, float acc) const {
        if (n < 512) kb[(size_t)m * 512 + n] = f2bf(acc);
        else { const int b = m >> 8, mm = m & 255, hd = n - 512; vT[((size_t)b * 512 + hd) * 256 + mm] = f2bf(acc); }
    }
};
struct EpiGlu {
    const bf16_t* yap; const float* b_glu; bf16_t* yag;
    __device__ void operator()(int m, int n, float acc) const { const float y = bf2f(yap[(size_t)m * 512 + n]); yag[(size_t)m * 512 + n] = f2bf(y * sigm(acc + b_glu[n])); }
};
struct EpiWout {
    const float* x; float* x1; bf16_t* x1b;
    __device__ void operator()(int m, int n, float acc) const { const float v = x[(size_t)m * D + n] + acc; x1[(size_t)m * D + n] = v; x1b[(size_t)m * D + n] = f2bf(v); }
};
struct EpiDown {
    float* x1;
    __device__ void operator()(int m, int n, float acc) const { x1[(size_t)m * D + n] += acc; }
};
__global__ void __launch_bounds__(64) k_s5_naive(const bf16_t* __restrict__ Ag, const float* a_re, const float* a_im, const float* log_dt, const float* bm_re, const float* bm_im,
                                                 const float* cm_re, const float* cm_im, const float* d_skip, bf16_t* __restrict__ yap) {
    const int b = blockIdx.x >> 5, g = blockIdx.x & 31, p = threadIdx.x;
    const float dt = expf(log_dt[g]), ar = a_re[g * 64 + p], ai = a_im[g * 64 + p];
    const float mag = expf(ar * dt), abr = mag * cosf(ai * dt), abi = mag * sinf(ai * dt);
    const float nr = abr - 1.f, den = ar * ar + ai * ai, fre = (nr * ar + abi * ai) / den, fim = (abi * ar - nr * ai) / den;
    float bbr[16], bbi[16], cr[16], ci[16];
#pragma unroll
    for (int h = 0; h < 16; ++h) {
        const float br = bm_re[(g * 64 + p) * 16 + h], bi = bm_im[(g * 64 + p) * 16 + h];
        bbr[h] = fre * br - fim * bi; bbi[h] = fre * bi + fim * br;
        cr[h] = cm_re[(g * 16 + h) * 64 + p]; ci[h] = cm_im[(g * 16 + h) * 64 + p];
    }
    const float dsk = d_skip[g * 16 + (p & 15)];
    float sr = 0.f, si = 0.f;
    for (int t = 0; t < SEQ; ++t) {
        const int tg = b * SEQ + t;
        const bf16_t* up = Ag + ((size_t)g * NCH + (tg >> 4)) * KE + (tg & 15) * 16;
        const uint4 u0 = *(const uint4*)up, u1 = *(const uint4*)(up + 8);
        float u[16];
        u[0] = __uint_as_float(u0.x << 16); u[1] = __uint_as_float(u0.x & 0xffff0000u); u[2] = __uint_as_float(u0.y << 16); u[3] = __uint_as_float(u0.y & 0xffff0000u);
        u[4] = __uint_as_float(u0.z << 16); u[5] = __uint_as_float(u0.z & 0xffff0000u); u[6] = __uint_as_float(u0.w << 16); u[7] = __uint_as_float(u0.w & 0xffff0000u);
        u[8] = __uint_as_float(u1.x << 16); u[9] = __uint_as_float(u1.x & 0xffff0000u); u[10] = __uint_as_float(u1.y << 16); u[11] = __uint_as_float(u1.y & 0xffff0000u);
        u[12] = __uint_as_float(u1.z << 16); u[13] = __uint_as_float(u1.z & 0xffff0000u); u[14] = __uint_as_float(u1.w << 16); u[15] = __uint_as_float(u1.w & 0xffff0000u);
        float bur = 0.f, bui = 0.f;
#pragma unroll
        for (int h = 0; h < 16; ++h) { bur += bbr[h] * u[h]; bui += bbi[h] * u[h]; }
        const float nsr = abr * sr - abi * si + bur, nsi = abr * si + abi * sr + bui; sr = nsr; si = nsi;
        float mine = 0.f, um = 0.f;
#pragma unroll
        for (int h = 0; h < 16; ++h) { const float y = wave_sum(cr[h] * sr - ci[h] * si); if (p == h) { mine = y; um = u[h]; } }
        if (p < 16) yap[(size_t)tg * 512 + g * 16 + p] = f2bf(gelu_t(mine + dsk * um));
    }
}
__global__ void __launch_bounds__(256) k_attn_naive(const bf16_t* __restrict__ q, const bf16_t* __restrict__ kb, const bf16_t* __restrict__ vT, bf16_t* __restrict__ o) {
    __shared__ float sc[256]; __shared__ float red[8];
    const int t = blockIdx.x >> 2, h = blockIdx.x & 3, b = t / SEQ, tid = threadIdx.x, lane = tid & 63, w = tid >> 6;
    const float s = dotrow(q + (size_t)t * 512 + h * 128, kb + (size_t)(b * 256 + tid) * 512 + h * 128, 128);
    float mx = wave_max(s); if (lane == 0) red[w] = mx; __syncthreads();
    mx = fmaxf(fmaxf(red[0], red[1]), fmaxf(red[2], red[3]));
    const float e = expf(s - mx); float sm = wave_sum(e); if (lane == 0) red[4 + w] = sm; __syncthreads();
    sm = red[4] + red[5] + red[6] + red[7];
    sc[tid] = e / sm; __syncthreads();
    if (tid < 128) {
        const bf16_t* vr = vT + ((size_t)b * 512 + h * 128 + tid) * 256; float acc = 0.f;
        for (int m = 0; m < 256; ++m) acc += sc[m] * bf2f(vr[m]);
        o[(size_t)t * 512 + h * 128 + tid] = f2bf(acc);
    }
}
__global__ void __launch_bounds__(512) k_sgu_stats(const bf16_t* __restrict__ gv, float* __restrict__ st) {
    const int row = blockIdx.x * 8 + (threadIdx.x >> 6), lane = threadIdx.x & 63;
    const uint4 r = ((const uint4*)(gv + (size_t)row * 512))[lane];
    float v[8]; v[0] = __uint_as_float(r.x << 16); v[1] = __uint_as_float(r.x & 0xffff0000u); v[2] = __uint_as_float(r.y << 16); v[3] = __uint_as_float(r.y & 0xffff0000u);
    v[4] = __uint_as_float(r.z << 16); v[5] = __uint_as_float(r.z & 0xffff0000u); v[6] = __uint_as_float(r.w << 16); v[7] = __uint_as_float(r.w & 0xffff0000u);
    float s = 0.f;
#pragma unroll
    for (int j = 0; j < 8; ++j) s += v[j];
    const float mu = wave_sum(s) * (1.f / 512.f); float q = 0.f;
#pragma unroll
    for (int j = 0; j < 8; ++j) { const float d = v[j] - mu; q += d * d; }
    const float rstd = rsqrtf(wave_sum(q) * (1.f / 512.f) + EPS);
    if (lane == 0) { st[row * 2] = mu; st[row * 2 + 1] = rstd; }
}
__global__ void __launch_bounds__(256) k_sgu_naive(const bf16_t* __restrict__ gu, const bf16_t* __restrict__ gv, const float* __restrict__ st, const bf16_t* __restrict__ Wm, const float* __restrict__ b_s,
                                                   const float* __restrict__ g_sgu, const float* __restrict__ beta, bf16_t* __restrict__ out) {
    const int c = blockIdx.x * 256 + threadIdx.x, t = blockIdx.y, tt = t & 127, t0 = t - tt, g = c >> 7;
    const float gam = g_sgu[c], bet = beta[c];
    float sv = b_s[g * 128 + tt];
    for (int s = 0; s <= tt; ++s) { const float v = (bf2f(gv[(size_t)(t0 + s) * 512 + c]) - st[(t0 + s) * 2]) * st[(t0 + s) * 2 + 1] * gam + bet; sv += bf2f(Wm[(g * 128 + tt) * 128 + s]) * v; }
    out[(size_t)t * 512 + c] = f2bf(bf2f(gu[(size_t)t * 512 + c]) * sv);
}
__global__ void __launch_bounds__(256) k_merge_naive(const bf16_t* __restrict__ yag, const bf16_t* __restrict__ sgu, const bf16_t* __restrict__ o, const bf16_t* __restrict__ WaT, const bf16_t* __restrict__ WbT,
                                                     const bf16_t* __restrict__ WcT, const bf16_t* __restrict__ gates, bf16_t* __restrict__ merged) {
    const int n = blockIdx.x * 64 + (threadIdx.x & 63), m = blockIdx.y * 4 + (threadIdx.x >> 6);
    const float ya = dotrow(yag + (size_t)m * 512, WaT + (size_t)n * 512, 512), yb = dotrow(sgu + (size_t)m * 512, WbT + (size_t)n * 512, 512), yc = dotrow(o + (size_t)m * 512, WcT + (size_t)n * 512, 512);
    const bf16_t* gr = gates + (size_t)m * 3072 + n;
    merged[(size_t)m * D + n] = f2bf(bf2f(gr[0]) * ya + bf2f(gr[1024]) * yb + bf2f(gr[2048]) * yc);
}
__global__ void __launch_bounds__(256) k_ffnup_naive(const bf16_t* __restrict__ x1b, const bf16_t* __restrict__ WguT, const float* __restrict__ ss1, bf16_t* __restrict__ act) {
    const int j = blockIdx.x * 64 + (threadIdx.x & 63), m = blockIdx.y * 4 + (threadIdx.x >> 6);
    const int r0 = 256 * (j >> 7) + (j & 127);
    const float G = dotrow(x1b + (size_t)m * D, WguT + (size_t)r0 * D, D), U = dotrow(x1b + (size_t)m * D, WguT + (size_t)(r0 + 128) * D, D);
    const float rs = rsqrtf(ss1[m] * (1.f / D) + EPS), gg = rs * G;
    act[(size_t)m * DFF + j] = f2bf(gg * sigm(gg) * (rs * U));
}
__global__ void __launch_bounds__(512) k_rowss(const float* __restrict__ x, float* __restrict__ ss) {
    const int row = blockIdx.x * 8 + (threadIdx.x >> 6), lane = threadIdx.x & 63;
    const float4* xr = (const float4*)(x + (size_t)row * D) + lane; float s = 0.f;
#pragma unroll
    for (int j = 0; j < 4; ++j) { const float4 v = xr[64 * j]; s += v.x * v.x + v.y * v.y + v.z * v.z + v.w * v.w; }
    s = wave_sum(s); if (lane == 0) ss[row] = s;
}
__global__ void __launch_bounds__(256) k_final(float* __restrict__ x, const float* __restrict__ ss, const float* __restrict__ g) {
    const size_t i = (size_t)blockIdx.x * 256 + threadIdx.x; const int row = (int)(i >> 8), c4 = (int)(i & 255);
    const float rs = rsqrtf(ss[row] * (1.f / D) + EPS);
    float4 v = ((float4*)x)[i]; const float4 gg = ((const float4*)g)[c4];
    v.x *= rs * gg.x; v.y *= rs * gg.y; v.z *= rs * gg.z; v.w *= rs * gg.w; ((float4*)x)[i] = v;
}

#define LAS __attribute__((address_space(3)))
typedef short bf16x8 __attribute__((ext_vector_type(8)));
typedef float f32x4 __attribute__((ext_vector_type(4)));
typedef float f32x2 __attribute__((ext_vector_type(2)));
typedef unsigned u32x4 __attribute__((ext_vector_type(4)));
typedef unsigned u32x2 __attribute__((ext_vector_type(2)));
typedef __bf16 bf16x2_t __attribute__((ext_vector_type(2)));

constexpr int NWAVES = 8, NTHREADS = 512;
constexpr int BM = 256, BK = 64, HALF = 128, HTB = HALF * BK * 2, NXCD = 8, WGM = 8;
constexpr int RING_BYTES = 131072, LDS_BYTES = 147456, LDSCTL_OFF = LDS_BYTES - 512;
constexpr int CW_BAR = 4096;
enum { W_PREP = 1, W_INPROJ = 2, W_KV = 4, W_S5L = 8, W_SGU = 16, W_S5Y = 32, W_ATTN = 64, W_GLU = 128, W_MERGE = 256, W_WOUT = 512, W_FFNUP = 1024, W_FFNDOWN = 2048, W_FINAL = 4096, W_ALL = 8191 };

#define LDS_WAIT() asm volatile("s_waitcnt lgkmcnt(0)" ::: "memory")
#define VM_WAIT() asm volatile("s_waitcnt vmcnt(0)" ::: "memory")
__device__ __forceinline__ unsigned cvtpk(float lo, float hi) { f32x2 v = {lo, hi}; bf16x2_t b = __builtin_convertvector(v, bf16x2_t); return __builtin_bit_cast(unsigned, b); }
__device__ __forceinline__ u32x4 pack8(const f32x4 a, const f32x4 b) { u32x4 w; w.x = cvtpk(a[0], a[1]); w.y = cvtpk(a[2], a[3]); w.z = cvtpk(b[0], b[1]); w.w = cvtpk(b[2], b[3]); return w; }
__device__ __forceinline__ f32x4 unpk_lo(const u32x4 w) { return (f32x4){__uint_as_float(w.x << 16), __uint_as_float(w.x & 0xffff0000u), __uint_as_float(w.y << 16), __uint_as_float(w.y & 0xffff0000u)}; }
__device__ __forceinline__ f32x4 unpk_hi(const u32x4 w) { return (f32x4){__uint_as_float(w.z << 16), __uint_as_float(w.z & 0xffff0000u), __uint_as_float(w.w << 16), __uint_as_float(w.w & 0xffff0000u)}; }
__device__ __forceinline__ float sigm_f(float x) { return __builtin_amdgcn_rcpf(1.f + __builtin_amdgcn_exp2f(-1.4426950408889634f * x)); }
__device__ __forceinline__ float gelu_f(float x) { const float u2 = 1.5957691216057308f * (x + 0.044715f * x * x * x); return x * sigm_f(u2); }
__device__ __forceinline__ f32x4 gelu4(const f32x4 v) { return (f32x4){gelu_f(v[0]), gelu_f(v[1]), gelu_f(v[2]), gelu_f(v[3])}; }
__device__ __forceinline__ f32x4 sigm4(const f32x4 v) { return (f32x4){sigm_f(v[0]), sigm_f(v[1]), sigm_f(v[2]), sigm_f(v[3])}; }
__device__ __forceinline__ f32x4 rcp4(const f32x4 v) { return (f32x4){__builtin_amdgcn_rcpf(v[0]), __builtin_amdgcn_rcpf(v[1]), __builtin_amdgcn_rcpf(v[2]), __builtin_amdgcn_rcpf(v[3])}; }

#define XB_TMO      128
#define XB_XCNT(j)  (256  + 64 * (j))
#define XB_XSUB(j)  (1280 + 64 * (j))
#define XB_XGEN(j)  (2304 + 64 * (j))
#define XB_TOP      3328
#define XB_TOPGEN   3392
#define XCD_BAR_WORDS 3456
#define XB_SPIN_CAP (1u << 18)
__device__ __forceinline__ unsigned xb_ld(unsigned* p)              { return __hip_atomic_load(p, __ATOMIC_RELAXED, __HIP_MEMORY_SCOPE_AGENT); }
__device__ __forceinline__ unsigned xb_add(unsigned* p, unsigned v) { return __hip_atomic_fetch_add(p, v, __ATOMIC_RELAXED, __HIP_MEMORY_SCOPE_AGENT); }
__device__ __forceinline__ unsigned xb_xcc_id() { return (unsigned)__builtin_amdgcn_s_getreg((3 << 11) | 20) & 0xFu; }
#define XB_SPIN(cond, bar) do { unsigned _sp = 0; while (cond) { __builtin_amdgcn_s_sleep(1); \
    if ((++_sp & 255u) == 0u) { if (xb_ld(&(bar)[XB_TMO])) break; if (_sp > XB_SPIN_CAP) { atomicAdd(&(bar)[XB_TMO], 1u); break; } } } } while (0)
struct XcdBarrier { unsigned* bar; unsigned x; volatile LAS unsigned* st; };
__device__ __forceinline__ XcdBarrier xcd_barrier_post(unsigned* bar, volatile LAS unsigned* st) {
    XcdBarrier b; b.bar = bar; b.x = xb_xcc_id(); b.st = st;
    if (threadIdx.x == 0) (void)xb_add(&bar[XB_XCNT(b.x)], 1u);
    return b;
}
__device__ __forceinline__ void xcd_barrier_complete(unsigned* bar, unsigned x, unsigned& nloc, unsigned& nx) {
    const unsigned G = gridDim.x * gridDim.y * gridDim.z;
    unsigned sum, cnt, mine, sp = 0u;
    for (;;) {
        sum = 0u; cnt = 0u; mine = 0u;
#pragma unroll
        for (unsigned j = 0; j < 16; ++j) { const unsigned c = xb_ld(&bar[XB_XCNT(j)]); sum += c; cnt += (c > 0u) ? 1u : 0u; mine = (j == x) ? c : mine; }
        if (sum == G) break;
        __builtin_amdgcn_s_sleep(1);
        if ((++sp & 255u) == 0u) { if (xb_ld(&bar[XB_TMO])) break; if (sp > XB_SPIN_CAP) { atomicAdd(&bar[XB_TMO], 1u); break; } }
    }
    nloc = mine > 0u ? mine : 1u; nx = cnt > 0u ? cnt : 1u;
}
__device__ __forceinline__ void xcd_barrier(const XcdBarrier& b) {
    asm volatile("s_waitcnt vmcnt(0)" ::: "memory");
    __syncthreads();
    if (threadIdx.x == 0) {
        unsigned* bar = b.bar;
        __builtin_amdgcn_s_waitcnt(0);
        unsigned nloc = b.st[0], nx = b.st[1];
        if (nloc == 0u) { xcd_barrier_complete(bar, b.x, nloc, nx); b.st[0] = nloc; b.st[1] = nx; }
        const unsigned old = xb_add(&bar[XB_XSUB(b.x)], 1u);
        const unsigned gen = old / nloc;
        if (old + 1u == (gen + 1u) * nloc) {
            __builtin_amdgcn_fence(__ATOMIC_RELEASE, "agent");
            asm volatile("s_waitcnt vmcnt(0)" ::: "memory");
            const unsigned og = xb_add(&bar[XB_TOP], 1u);
            const unsigned tg = og / nx;
            if (og + 1u == (tg + 1u) * nx) xb_add(&bar[XB_TOPGEN], 1u);
            else XB_SPIN(xb_ld(&bar[XB_TOPGEN]) == tg, bar);
            __builtin_amdgcn_fence(__ATOMIC_ACQUIRE, "agent");
            xb_add(&bar[XB_XGEN(b.x)], 1u);
            asm volatile("s_waitcnt vmcnt(0)" ::: "memory");
        } else {
            XB_SPIN(xb_ld(&bar[XB_XGEN(b.x)]) == gen, bar);
            __builtin_amdgcn_fence(__ATOMIC_ACQUIRE, "agent");
            asm volatile("s_waitcnt vmcnt(0)" ::: "memory");
        }
    }
    __syncthreads();
}

__host__ __device__ __forceinline__ int lds_byte(int r, int c) { const int st = (r >> 4) * 2 + (c >> 5), rr = r & 15, cc = c & 31, ob = rr * 64 + cc * 2; return st * 1024 + (ob ^ (((ob >> 9) & 1) << 5)); }
__host__ __device__ __forceinline__ void stage_rc(int b, int& R, int& C) { const int st = b / 1024, sb = b % 1024, swz = sb ^ (((sb >> 9) & 1) << 5); R = (st >> 1) * 16 + swz / 64; C = (st & 1) * 32 + (swz % 64) / 2; }
__host__ __device__ __forceinline__ int perm32(int rho) { const int n = rho >> 4, i = rho & 15; return 8 * (i >> 2) + 4 * n + (i & 3); }
struct Unit { const char* a; const char* b; int pm, pn, sub; };

struct TileOrder {
    int nM, nN, nwg, G, c; const char* A; const char* B; size_t ta, tb;
    __device__ __forceinline__ void init(int M, int N, int G_, int c_, const void* A_, int lda, const void* B_, int ldb) { nM = M / BM; nN = N / BM; nwg = nM * nN; G = G_; c = c_; A = (const char*)A_; B = (const char*)B_; ta = (size_t)BM * lda * 2; tb = (size_t)BM * ldb * 2; }
    __device__ __forceinline__ bool tile(long L, int& pm, int& pn) const {
        if (L >= nwg) return false;
        int wgid = (int)L; { const int q = nwg / NXCD, r = nwg % NXCD, xcd = wgid % NXCD, off = wgid / NXCD; wgid = (xcd < r ? xcd * (q + 1) : r * (q + 1) + (xcd - r) * q) + off; }
        const int nig = WGM * nN, gid = wgid / nig, fm = gid * WGM, gsz = (nM - fm) < WGM ? (nM - fm) : WGM;
        pm = fm + ((wgid % nig) % gsz); pn = (wgid % nig) / gsz; return true;
    }
    __device__ __forceinline__ bool next(int i, Unit& u) const { if (!tile((long)i * G + c, u.pm, u.pn)) return false; u.a = A + (size_t)u.pm * ta; u.b = B + (size_t)u.pn * tb; u.sub = 0; return true; }
};

template <class Epi, class Sched>
__device__ __forceinline__ void gemm_phase(LAS unsigned char* lds, const int lda, const int ldb, const int nt, const Sched S, const Epi E) {
    const int tid = threadIdx.x, wid = __builtin_amdgcn_readfirstlane(tid >> 6), lane = tid & 63, wr = wid >> 2, wc = wid & 3, fr = lane & 15, fq = lane >> 4;
    unsigned voffA[2], voffB[2];
#pragma unroll
    for (int i = 0; i < 2; ++i) { int R, C; stage_rc(tid * 16 + i * 8192, R, C); const int Rb = Epi::PERM ? ((R & ~31) + perm32(R & 31)) : R;
        voffA[i] = (unsigned)(R * lda + C) * 2u; voffB[i] = (unsigned)(Rb * ldb + C) * 2u; }
    const size_t kstep = (size_t)(BK * 2);
    const size_t hstepA = (size_t)HALF * lda * 2, hstepB = (size_t)HALF * ldb * 2;
    const unsigned ldsw = (unsigned)wid * 1024u;
    const int aoff = lds_byte(wr * 64 + fr, fq * 8), boff = lds_byte(wc * 32 + fr, fq * 8);
#define PG8_SA(b, h) (((b) * 2 + (h)) * HTB)
#define PG8_SB(b, h) ((4 + (b) * 2 + (h)) * HTB)
#define PG8_STAGE(bufoff, gbase, voff) do { _Pragma("unroll") for (int _i = 0; _i < 2; ++_i) \
        __builtin_amdgcn_global_load_lds((const unsigned*)((const char*)(gbase) + (voff)[_i]), (LAS unsigned*)(lds + (bufoff) + ldsw + _i * 8192), 16, 0, 0); } while (0)
#define PG8_LDA(dst, b, h) do { _Pragma("unroll") for (int m = 0; m < 4; ++m) _Pragma("unroll") for (int k = 0; k < 2; ++k) dst[m][k] = *(const LAS bf16x8*)(lds + PG8_SA(b, h) + aoff + m * 2048 + k * 1024); } while (0)
#define PG8_LDB(dst, b, h) do { _Pragma("unroll") for (int n = 0; n < 2; ++n) _Pragma("unroll") for (int k = 0; k < 2; ++k) dst[n][k] = *(const LAS bf16x8*)(lds + PG8_SB(b, h) + boff + n * 2048 + k * 1024); } while (0)
#define PG8_MMA(ai, bj, At, Bt) do { __builtin_amdgcn_s_setprio(1); _Pragma("unroll") for (int m = 0; m < 4; ++m) _Pragma("unroll") for (int n = 0; n < 2; ++n) _Pragma("unroll") for (int k = 0; k < 2; ++k) \
        acc[ai][bj][m][n] = __builtin_amdgcn_mfma_f32_16x16x32_bf16(Bt[n][k], At[m][k], acc[ai][bj][m][n], 0, 0, 0); __builtin_amdgcn_s_setprio(0); } while (0)
#define PG8_WAIT_V(n) asm volatile("s_waitcnt vmcnt(" #n ")" ::: "memory")
#define PG8_WAIT_L(n) asm volatile("s_waitcnt lgkmcnt(" #n ")" ::: "memory")
#define PG8_BAR __builtin_amdgcn_s_barrier()
#define PG8_SCHED __builtin_amdgcn_sched_barrier(0)
    Unit cur, nxt; int ui = 0;
    if (!S.next(0, cur)) return;
    f32x4 acc[2][2][4][2];
#pragma unroll
    for (int a = 0; a < 2; ++a)
#pragma unroll
        for (int b = 0; b < 2; ++b)
#pragma unroll
            for (int m = 0; m < 4; ++m)
#pragma unroll
                for (int n = 0; n < 2; ++n) acc[a][b][m][n] = (f32x4){0.f, 0.f, 0.f, 0.f};
    bf16x8 At[4][2], B0[2][2], B1[2][2];
    const char* cA = cur.a; const char* cB = cur.b;
    PG8_STAGE(PG8_SB(0, 0), cB, voffB); PG8_STAGE(PG8_SB(0, 1), cB + hstepB, voffB); PG8_STAGE(PG8_SA(0, 0), cA, voffA); PG8_STAGE(PG8_SA(0, 1), cA + hstepA, voffA);
    if (wr == 1) PG8_BAR;
    PG8_WAIT_V(2); PG8_BAR;
    PG8_STAGE(PG8_SB(1, 0), cB + kstep, voffB); PG8_STAGE(PG8_SA(1, 0), cA + kstep, voffA); PG8_STAGE(PG8_SB(1, 1), cB + hstepB + kstep, voffB);
    PG8_WAIT_V(6); PG8_BAR;
    for (;;) {
        const bool has_next = S.next(ui + 1, nxt);
        const char* nA = has_next ? nxt.a : cA; const char* nB = has_next ? nxt.b : cB;
#pragma unroll 1
        for (int t = 0; t < nt; t += 2) {
            const bool last = (t == nt - 2);
            const char* a1 = cA + (size_t)(t + 1) * kstep;
            const char* a2 = last ? nA : cA + (size_t)(t + 2) * kstep; const char* b2 = last ? nB : cB + (size_t)(t + 2) * kstep;
            const char* a3 = a2 + kstep; const char* b3 = b2 + kstep;
            PG8_LDB(B0, 0, 0); PG8_LDB(B1, 0, 1); PG8_SCHED; PG8_LDA(At, 0, 0); PG8_STAGE(PG8_SA(1, 1), a1 + hstepA, voffA);
            PG8_WAIT_V(8); PG8_WAIT_L(0); PG8_BAR; PG8_MMA(0, 0, At, B0); PG8_MMA(0, 1, At, B1); PG8_BAR; PG8_SCHED;
            PG8_LDA(At, 0, 1); PG8_STAGE(PG8_SB(0, 0), b2, voffB); PG8_STAGE(PG8_SB(0, 1), b2 + hstepB, voffB); PG8_STAGE(PG8_SA(0, 0), a2, voffA);
            PG8_WAIT_V(8); PG8_WAIT_L(0); PG8_BAR; PG8_MMA(1, 0, At, B0); PG8_MMA(1, 1, At, B1); PG8_BAR; PG8_SCHED;
            PG8_LDB(B0, 1, 0); PG8_LDB(B1, 1, 1); PG8_SCHED; PG8_LDA(At, 1, 0); PG8_STAGE(PG8_SA(0, 1), a2 + hstepA, voffA);
            PG8_WAIT_V(8); PG8_WAIT_L(0); PG8_BAR; PG8_MMA(0, 0, At, B0); PG8_MMA(0, 1, At, B1); PG8_BAR; PG8_SCHED;
            PG8_LDA(At, 1, 1); PG8_STAGE(PG8_SB(1, 0), b3, voffB); PG8_STAGE(PG8_SB(1, 1), b3 + hstepB, voffB); PG8_STAGE(PG8_SA(1, 0), a3, voffA);
            PG8_WAIT_V(8); PG8_WAIT_L(0); PG8_BAR; PG8_MMA(1, 0, At, B0); PG8_MMA(1, 1, At, B1); PG8_BAR; PG8_SCHED;
        }
        if (wr == 0) PG8_BAR;
        const bool reset = E(acc, cur, wr, wc, fr, fq);
        if (!has_next) break;
        if (reset) {
#pragma unroll
            for (int a = 0; a < 2; ++a)
#pragma unroll
                for (int b = 0; b < 2; ++b)
#pragma unroll
                    for (int m = 0; m < 4; ++m)
#pragma unroll
                        for (int n = 0; n < 2; ++n) acc[a][b][m][n] = (f32x4){0.f, 0.f, 0.f, 0.f};
        }
        cur = nxt; cA = nA; cB = nB; ++ui;
        if (wr == 1) PG8_BAR;
    }
    PG8_WAIT_V(0);
    PG8_BAR;
#undef PG8_SA
#undef PG8_SB
#undef PG8_STAGE
#undef PG8_LDA
#undef PG8_LDB
#undef PG8_MMA
#undef PG8_WAIT_V
#undef PG8_WAIT_L
#undef PG8_BAR
#undef PG8_SCHED
}

typedef f32x4 (&AccRef)[2][2][4][2];
#define EPI_LOOP_AM _Pragma("unroll") for (int ai = 0; ai < 2; ++ai) _Pragma("unroll") for (int m = 0; m < 4; ++m)
struct EpiInprojM {
    static constexpr bool PERM = true;
    bf16_t *Ag, *gu, *gv, *q, *gates; const float* b_gate;
    __device__ __forceinline__ bool operator()(AccRef acc, const Unit& u, int wr, int wc, int fr, int fq) const {
        const int row0 = u.pm * BM + wr * 64 + fr, cl = wc * 32 + 8 * fq, pn = u.pn;
        if (pn < 2) {
            EPI_LOOP_AM { const int row = row0 + ai * HALF + m * 16;
#pragma unroll
                for (int bj = 0; bj < 2; ++bj) { const int c = pn * 256 + bj * HALF + cl, g = c >> 4, hp = c & 15;
                    *(u32x4*)(Ag + ((size_t)(g * NCH + (row >> 4)) * KE + (row & 15) * 16 + hp)) = pack8(acc[ai][bj][m][0], acc[ai][bj][m][1]); } }
        } else if (pn < 6) {
            bf16_t* base = (pn < 4 ? gu : gv) + (pn & 1) * 256 + cl;
            EPI_LOOP_AM { const int row = row0 + ai * HALF + m * 16;
#pragma unroll
                for (int bj = 0; bj < 2; ++bj) *(u32x4*)(base + (size_t)row * 512 + bj * HALF) = pack8(gelu4(acc[ai][bj][m][0]), gelu4(acc[ai][bj][m][1])); }
        } else if (pn < 8) {
            bf16_t* base = q + (pn & 1) * 256 + cl;
            EPI_LOOP_AM { const int row = row0 + ai * HALF + m * 16;
#pragma unroll
                for (int bj = 0; bj < 2; ++bj) *(u32x4*)(base + (size_t)row * 512 + bj * HALF) = pack8(acc[ai][bj][m][0] * 0.08838834764831845f, acc[ai][bj][m][1] * 0.08838834764831845f); }
        } else {
            const int cg = (pn - 8) * 256 + cl;
            f32x4 bv[2][2];
#pragma unroll
            for (int bj = 0; bj < 2; ++bj) { bv[bj][0] = *(const f32x4*)(b_gate + cg + bj * HALF); bv[bj][1] = *(const f32x4*)(b_gate + cg + bj * HALF + 4); }
            EPI_LOOP_AM { const int row = row0 + ai * HALF + m * 16;
#pragma unroll
                for (int bj = 0; bj < 2; ++bj) *(u32x4*)(gates + (size_t)row * 3072 + cg + bj * HALF) = pack8(sigm4(acc[ai][bj][m][0] + bv[bj][0]), sigm4(acc[ai][bj][m][1] + bv[bj][1])); }
        }
        return true;
    }
};
struct EpiKVM {
    static constexpr bool PERM = true;
    bf16_t *kb, *vT;
    __device__ __forceinline__ bool operator()(AccRef acc, const Unit& u, int wr, int wc, int fr, int fq) const {
        const int row0 = u.pm * BM + wr * 64 + fr, cl = wc * 32 + 8 * fq, pn = u.pn;
        if (pn < 2) {
            EPI_LOOP_AM { const int row = row0 + ai * HALF + m * 16;
#pragma unroll
                for (int bj = 0; bj < 2; ++bj) *(u32x4*)(kb + (size_t)row * 512 + pn * 256 + bj * HALF + cl) = pack8(acc[ai][bj][m][0], acc[ai][bj][m][1]); }
        } else {
            EPI_LOOP_AM { const int row = row0 + ai * HALF + m * 16, b = row >> 8, mm = row & 255;
#pragma unroll
                for (int bj = 0; bj < 2; ++bj) { const int hd = (pn - 2) * 256 + bj * HALF + cl; bf16_t* dst = vT + ((size_t)b * 512 + hd) * 256 + mm;
#pragma unroll
                    for (int n = 0; n < 2; ++n)
#pragma unroll
                        for (int j = 0; j < 4; ++j) dst[(size_t)(n * 4 + j) * 256] = (bf16_t)(cvtpk(acc[ai][bj][m][n][j], 0.f) & 0xffffu); } }
        }
        return true;
    }
};
struct EpiS5YM {
    static constexpr bool PERM = true;
    bf16_t* yap;
    __device__ __forceinline__ bool operator()(AccRef acc, const Unit& u, int wr, int wc, int fr, int fq) const {
        const int g = u.pm >> 2, mch0 = (u.pm & 3) * BM + wr * 64 + fr, cl = wc * 32 + 8 * fq;
        EPI_LOOP_AM { const int mch = mch0 + ai * HALF + m * 16;
#pragma unroll
            for (int bj = 0; bj < 2; ++bj) { const int n = bj * HALF + cl, tau = n >> 4, hh = n & 15; const size_t tg = (size_t)mch * 16 + tau;
                *(u32x4*)(yap + tg * 512 + g * 16 + hh) = pack8(gelu4(acc[ai][bj][m][0]), gelu4(acc[ai][bj][m][1])); } }
        return true;
    }
};
struct EpiGluM {
    static constexpr bool PERM = true;
    const bf16_t* yap; const float* b_glu; bf16_t* yag;
    __device__ __forceinline__ bool operator()(AccRef acc, const Unit& u, int wr, int wc, int fr, int fq) const {
        const int row0 = u.pm * BM + wr * 64 + fr, c0 = u.pn * 256 + wc * 32 + 8 * fq;
        f32x4 bv[2][2];
#pragma unroll
        for (int bj = 0; bj < 2; ++bj) { bv[bj][0] = *(const f32x4*)(b_glu + c0 + bj * HALF); bv[bj][1] = *(const f32x4*)(b_glu + c0 + bj * HALF + 4); }
        EPI_LOOP_AM { const size_t ro = (size_t)(row0 + ai * HALF + m * 16) * 512 + c0;
#pragma unroll
            for (int bj = 0; bj < 2; ++bj) { const u32x4 yv = *(const u32x4*)(yap + ro + bj * HALF);
                *(u32x4*)(yag + ro + bj * HALF) = pack8(unpk_lo(yv) * sigm4(acc[ai][bj][m][0] + bv[bj][0]), unpk_hi(yv) * sigm4(acc[ai][bj][m][1] + bv[bj][1])); } }
        return true;
    }
};
struct EpiMergeM {
    static constexpr bool PERM = true;
    const bf16_t* gates; bf16_t* merged;
    __device__ __forceinline__ bool operator()(AccRef acc, const Unit& u, int wr, int wc, int fr, int fq) const {
        const int row0 = u.pm * BM + wr * 64 + fr, c0 = u.pn * 256 + wc * 32 + 8 * fq, sub = u.sub;
        EPI_LOOP_AM { const int row = row0 + ai * HALF + m * 16; const bf16_t* gr = gates + (size_t)row * 3072 + c0;
#pragma unroll
            for (int bj = 0; bj < 2; ++bj) {
                if (sub < 2) { const u32x4 nu = *(const u32x4*)(gr + sub * 1024 + bj * HALF), de = *(const u32x4*)(gr + (sub + 1) * 1024 + bj * HALF);
                    acc[ai][bj][m][0] = acc[ai][bj][m][0] * (unpk_lo(nu) * rcp4(unpk_lo(de))); acc[ai][bj][m][1] = acc[ai][bj][m][1] * (unpk_hi(nu) * rcp4(unpk_hi(de))); }
                else { const u32x4 g2 = *(const u32x4*)(gr + 2048 + bj * HALF);
                    *(u32x4*)(merged + (size_t)row * D + c0 + bj * HALF) = pack8(acc[ai][bj][m][0] * unpk_lo(g2), acc[ai][bj][m][1] * unpk_hi(g2)); } } }
        return sub == 2;
    }
};
struct EpiResM {
    static constexpr bool PERM = false;
    const float* base; float* out; bf16_t* ob; float* ss;
    __device__ __forceinline__ bool operator()(AccRef acc, const Unit& u, int wr, int wc, int fr, int fq) const {
        const int row0 = u.pm * BM + wr * 64 + fr, c0 = u.pn * 256 + wc * 32 + 4 * fq;
        EPI_LOOP_AM { const int row = row0 + ai * HALF + m * 16; const size_t ro = (size_t)row * D + c0; float s = 0.f;
#pragma unroll
            for (int bj = 0; bj < 2; ++bj)
#pragma unroll
                for (int n = 0; n < 2; ++n) { const f32x4 v = *(const f32x4*)(base + ro + bj * HALF + n * 16) + acc[ai][bj][m][n];
                    *(f32x4*)(out + ro + bj * HALF + n * 16) = v; s += (v[0] * v[0] + v[1] * v[1]) + (v[2] * v[2] + v[3] * v[3]);
                    if (ob) { u32x2 w; w.x = cvtpk(v[0], v[1]); w.y = cvtpk(v[2], v[3]); *(u32x2*)(ob + ro + bj * HALF + n * 16) = w; } }
            s += __shfl_xor(s, 16); s += __shfl_xor(s, 32);
            if (fq == 0) __hip_atomic_fetch_add(ss + row, s, __ATOMIC_RELAXED, __HIP_MEMORY_SCOPE_AGENT); }
        return true;
    }
};
struct EpiFfnUpM {
    static constexpr bool PERM = true;
    const float* ss1; bf16_t* act;
    __device__ __forceinline__ bool operator()(AccRef acc, const Unit& u, int wr, int wc, int fr, int fq) const {
        const int row0 = u.pm * BM + wr * 64 + fr, c0 = u.pn * 128 + wc * 32 + 8 * fq;
        EPI_LOOP_AM { const int row = row0 + ai * HALF + m * 16; const float rs = rsqrtf(ss1[row] * (1.f / D) + EPS);
            f32x4 o[2];
#pragma unroll
            for (int n = 0; n < 2; ++n) { const f32x4 gg = acc[ai][0][m][n] * rs, uu = acc[ai][1][m][n] * rs; o[n] = gg * sigm4(gg) * uu; }
            *(u32x4*)(act + (size_t)row * DFF + c0) = pack8(o[0], o[1]); }
        return true;
    }
};

struct MergeOrder { TileOrder T; const char *a0, *b0; long da1, da2, db1, db2; size_t ta, tb;
    __device__ __forceinline__ bool next(int i, Unit& u) const { const int j = i / 3, s = i - 3 * j; if (!T.tile((long)j * T.G + T.c, u.pm, u.pn)) return false;
        const long s1 = (s == 1) ? 1 : 0, s2 = (s == 2) ? 1 : 0;
        u.a = a0 + s1 * da1 + s2 * da2 + (size_t)u.pm * ta; u.b = b0 + s1 * db1 + s2 * db2 + (size_t)u.pn * tb; u.sub = s; return true; } };
struct S5YOrder { int G, c; const char* Ag; const char* Km;
    __device__ __forceinline__ bool next(int i, Unit& u) const { const int L = i * G + c; if (L >= 128) return false; const int g = L >> 2, rt = L & 3;
        u.a = Ag + ((size_t)g * NCH + 256 * rt) * KE * 2; u.b = Km + (size_t)g * 256 * KE * 2; u.pm = L; u.pn = 0; u.sub = 0; return true; } };
struct KvOrder { int G, c; const char* A; const char* B;
    __device__ __forceinline__ bool next(int i, Unit& u) const { const int first = G >= 32 ? G - 32 : 0, str = G >= 32 ? 32 : G; if (c < first) return false; const int L = i * str + (c - first); if (L >= 32) return false;
        u.pm = L >> 2; u.pn = L & 3; u.a = A + (size_t)u.pm * BM * D * 2; u.b = B + (size_t)u.pn * BM * D * 2; u.sub = 0; return true; } };

__device__ __forceinline__ void p0_transpose_item(const float* __restrict__ W, int K, int N, bf16_t* __restrict__ WT, int ldt, const float* __restrict__ scale, int mode, LAS float* scr, int item, int lane) {
    const int nblk = N / 32, kb = item / nblk, nb = item % nblk, k0 = 64 * kb, n0 = 32 * nb;
#pragma unroll 8
    for (int i = 0; i < 32; ++i) { const int kk = 2 * i + (lane >> 5); float v = W[(size_t)(k0 + kk) * N + n0 + (lane & 31)]; if (scale) v *= scale[k0 + kk]; scr[kk * 33 + (lane & 31)] = v; }
    LDS_WAIT(); asm volatile("" ::: "memory");
    const int c = lane & 7;
#pragma unroll
    for (int j = 0; j < 4; ++j) { const int n = (lane >> 3) + 8 * j; const LAS float* s = scr + (8 * c) * 33 + n;
        u32x4 o; o.x = cvtpk(s[0 * 33], s[1 * 33]); o.y = cvtpk(s[2 * 33], s[3 * 33]); o.z = cvtpk(s[4 * 33], s[5 * 33]); o.w = cvtpk(s[6 * 33], s[7 * 33]);
        const int ng = n0 + n, drow = mode == 0 ? ng : 256 * (ng >> 7) + 128 * (mode - 1) + (ng & 127);
        *(u32x4*)(WT + (size_t)drow * ldt + k0 + 8 * c) = o; }
    LDS_WAIT(); asm volatile("" ::: "memory");
}
__device__ __forceinline__ void rms_row_bf16(const float* __restrict__ xrow, const float* __restrict__ g, bf16_t* __restrict__ orow, int lane) {
    const f32x4* xr = (const f32x4*)xrow + lane; f32x4 v[4]; float s = 0.f;
#pragma unroll
    for (int j = 0; j < 4; ++j) { v[j] = xr[64 * j]; s += (v[j][0] * v[j][0] + v[j][1] * v[j][1]) + (v[j][2] * v[j][2] + v[j][3] * v[j][3]); }
    const float rs = rsqrtf(wave_sum(s) * (1.f / D) + EPS);
#pragma unroll
    for (int j = 0; j < 4; ++j) { const f32x4 gg = ((const f32x4*)g)[64 * j + lane]; const f32x4 o = v[j] * rs * gg; u32x2 w; w.x = cvtpk(o[0], o[1]); w.y = cvtpk(o[2], o[3]); ((u32x2*)orow)[64 * j + lane] = w; }
}

struct MArgs { const float* in[30]; float* out; unsigned char* ws; int mask, bars; };

__device__ __forceinline__ void prep_phase(const MArgs& a, LAS unsigned char* lds, int G, int bx, int tid, int wave, int lane) {
    unsigned char* ws = a.ws;
    for (int blk = bx; blk < 256; blk += G) {
        const int g = blk >> 3, j = blk & 7;
        LAS float* E = (LAS float*)lds; LAS float* Bb = (LAS float*)(lds + 8704); LAS float* Kt = (LAS float*)(lds + 16896);
        if (tid < 64) {
            const int idx = g * 64 + tid;
            const double dt = (double)expf(a.in[7][g]), ar = a.in[5][idx], ai = a.in[6][idx];
            const double xm = ar * dt;
            double mag = 1.0; { double term = 1.0; for (int i = 1; i <= 12; ++i) { term *= xm / (double)i; mag += term; } }
            const double th = ai * dt, kq = __builtin_rint(th * 0.6366197723675814);
            const double r = __builtin_fma(-kq, 6.123233995736766e-17, __builtin_fma(-kq, 1.5707963267948966, th)), r2 = r * r;
            const double sr = r * (1.0 + r2 * (-1.0 / 6 + r2 * (1.0 / 120 + r2 * (-1.0 / 5040 + r2 * (1.0 / 362880 + r2 * (-1.0 / 39916800 + r2 * (1.0 / 6227020800.0)))))));
            const double cr = 1.0 + r2 * (-0.5 + r2 * (1.0 / 24 + r2 * (-1.0 / 720 + r2 * (1.0 / 40320 + r2 * (-1.0 / 3628800 + r2 * (1.0 / 479001600 + r2 * (-1.0 / 87178291200.0)))))));
            const int qd = ((int)kq) & 3;
            const double cs = (qd == 0) ? cr : (qd == 1) ? -sr : (qd == 2) ? -cr : sr, sn = (qd == 0) ? sr : (qd == 1) ? cr : (qd == 2) ? -sr : -cr;
            const double abr = mag * cs, abi = mag * sn;
            const double nr = abr - 1.0, den = ar * ar + ai * ai, fre = (nr * ar + abi * ai) / den, fim = (abi * ar - nr * ai) / den;
            double er = 1.0, ei = 0.0;
#pragma unroll 1
            for (int t = 0; t <= LC; ++t) { E[(tid * 17 + t) * 2] = (float)er; E[(tid * 17 + t) * 2 + 1] = (float)ei; const double n1 = er * abr - ei * abi, n2 = er * abi + ei * abr; er = n1; ei = n2; }
#pragma unroll 1
            for (int h = 0; h < 16; ++h) { const double br = a.in[8][idx * 16 + h], bi = a.in[9][idx * 16 + h]; Bb[(tid * 16 + h) * 2] = (float)(fre * br - fim * bi); Bb[(tid * 16 + h) * 2 + 1] = (float)(fre * bi + fim * br); }
        }
        __syncthreads();
        const float* cmr = a.in[10] + (size_t)g * 16 * 64; const float* cmi = a.in[11] + (size_t)g * 16 * 64;
#pragma unroll 1
        for (int i = 0; i < 8; ++i) {
            const int e = tid + 512 * i, tau = e >> 8, h = (e >> 4) & 15, hp = e & 15; float s = 0.f;
#pragma unroll 4
            for (int p = 0; p < 64; ++p) { const float er = E[(p * 17 + tau) * 2], ei = E[(p * 17 + tau) * 2 + 1], br = Bb[(p * 16 + hp) * 2], bi = Bb[(p * 16 + hp) * 2 + 1];
                s += cmr[h * 64 + p] * (er * br - ei * bi) - cmi[h * 64 + p] * (er * bi + ei * br); }
            if (tau == 0 && hp == h) s += a.in[12][g * 16 + h];
            Kt[e] = s;
        }
        __syncthreads();
        bf16_t* Km = (bf16_t*)(ws + WS_KMAT) + (size_t)g * 256 * KE; bf16_t* We = (bf16_t*)(ws + WS_WEND) + (size_t)g * 128 * 256;
#pragma unroll 1
        for (int i = 0; i < 24; ++i) {
            const int idx = tid + 512 * i, nl = idx / KE, k = idx - nl * KE, n = 32 * j + nl, to = n >> 4, h = n & 15; float val = 0.f;
            if (k < 256) { const int ti = k >> 4, hp = k & 15; if (ti <= to) val = Kt[(to - ti) * 256 + h * 16 + hp]; }
            else { const int pp = k - 256, p = pp & 63, im = pp >> 6; const float cr = cmr[h * 64 + p], ci = cmi[h * 64 + p], er = E[(p * 17 + to + 1) * 2], ei = E[(p * 17 + to + 1) * 2 + 1];
                val = im ? -(cr * ei + ci * er) : (cr * er - ci * ei); }
            Km[(size_t)n * KE + k] = f2bf(val);
        }
#pragma unroll 1
        for (int i = 0; i < 8; ++i) {
            const int idx = tid + 512 * i, ppl = idx >> 8, k = idx & 255, pp = 16 * j + ppl, p = pp & 63, im = pp >> 6, tau = k >> 4, hp = k & 15;
            const float er = E[(p * 17 + (LC - 1 - tau)) * 2], ei = E[(p * 17 + (LC - 1 - tau)) * 2 + 1], br = Bb[(p * 16 + hp) * 2], bi = Bb[(p * 16 + hp) * 2 + 1];
            We[(size_t)pp * 256 + k] = f2bf(im ? (er * bi + ei * br) : (er * br - ei * bi));
        }
        if (j == 0 && tid < 64) { float* a16 = (float*)(ws + WS_TABE) + (size_t)(g * 64 + tid) * 2; a16[0] = E[(tid * 17 + LC) * 2]; a16[1] = E[(tid * 17 + LC) * 2 + 1]; }
        __syncthreads();
    }
    LAS float* scr = (LAS float*)(lds + wave * 16384);
    const int gw = bx * NWAVES + wave, NGW = G * NWAVES;
    constexpr int I_IN = (D / 64) * (INW / 32), I_G = (D / 64) * (DFF / 32), I_D = (DFF / 64) * (D / 32), I_KV = (D / 64) * (1024 / 32), I_O = I_KV, I_ABC = (512 / 64) * (D / 32), I_GLU = (512 / 64) * (512 / 32);
    constexpr int NITEMS = I_IN + 2 * I_G + I_D + I_KV + I_O + 3 * I_ABC + I_GLU;
#pragma unroll 1
    for (int it = gw; it < NITEMS; it += NGW) {
        int r = it;
        if (r < I_IN) { p0_transpose_item(a.in[3], D, INW, (bf16_t*)(ws + WS_WIN), D, nullptr, 0, scr, r, lane); continue; } r -= I_IN;
        if (r < I_G) { p0_transpose_item(a.in[26], D, DFF, (bf16_t*)(ws + WS_WGU), D, a.in[25], 1, scr, r, lane); continue; } r -= I_G;
        if (r < I_G) { p0_transpose_item(a.in[27], D, DFF, (bf16_t*)(ws + WS_WGU), D, a.in[25], 2, scr, r, lane); continue; } r -= I_G;
        if (r < I_D) { p0_transpose_item(a.in[28], DFF, D, (bf16_t*)(ws + WS_WD), DFF, nullptr, 0, scr, r, lane); continue; } r -= I_D;
        if (r < I_KV) { p0_transpose_item(a.in[20], D, 1024, (bf16_t*)(ws + WS_WKV), D, nullptr, 0, scr, r, lane); continue; } r -= I_KV;
        if (r < I_O) { p0_transpose_item(a.in[24], D, D, (bf16_t*)(ws + WS_WOUT), D, nullptr, 0, scr, r, lane); continue; } r -= I_O;
        if (r < I_ABC) { p0_transpose_item(a.in[21], 512, D, (bf16_t*)(ws + WS_WA), 512, nullptr, 0, scr, r, lane); continue; } r -= I_ABC;
        if (r < I_ABC) { p0_transpose_item(a.in[22], 512, D, (bf16_t*)(ws + WS_WB), 512, nullptr, 0, scr, r, lane); continue; } r -= I_ABC;
        if (r < I_ABC) { p0_transpose_item(a.in[23], 512, D, (bf16_t*)(ws + WS_WC), 512, nullptr, 0, scr, r, lane); continue; } r -= I_ABC;
        p0_transpose_item(a.in[13], 512, 512, (bf16_t*)(ws + WS_WGLU), 512, nullptr, 0, scr, r, lane);
    }
#pragma unroll 1
    for (int r = gw; r < T + TM; r += NGW) {
        if (r < T) rms_row_bf16(a.in[0] + (size_t)r * D, a.in[2], (bf16_t*)(ws + WS_R1) + (size_t)r * D, lane);
        else rms_row_bf16(a.in[1] + (size_t)(r - T) * D, a.in[19], (bf16_t*)(ws + WS_MEMN) + (size_t)(r - T) * D, lane);
    }
    { bf16_t* Wm = (bf16_t*)(ws + WS_WM); const float* w_s = a.in[17];
      for (int e = bx * NTHREADS + tid; e < SGG * SGB * SGB; e += G * NTHREADS) { const int t = (e >> 7) & 127, s = e & 127; Wm[e] = (s <= t) ? f2bf(w_s[e]) : (bf16_t)0; } }
}
__device__ __forceinline__ void s5l_phase(const MArgs& a, LAS unsigned char* lds, int G, int bx, int tid, int wave, int lane) {
    unsigned char* ws = a.ws;
    bf16_t* Ag = (bf16_t*)(ws + WS_R2); const bf16_t* WendT = (const bf16_t*)(ws + WS_WEND); const float* A16 = (const float*)(ws + WS_TABE);
    const int fr = lane & 15, fq = lane >> 4;
    LAS float* L = (LAS float*)lds;
#pragma unroll 1
    for (int task = bx; task < 256; task += G) {
        const int g = task >> 3, b = task & 7;
        const bf16_t* Arow = Ag + ((size_t)g * NCH + b * 128 + wave * 16 + fr) * KE + fq * 8;
        bf16x8 af[8];
#pragma unroll
        for (int ks = 0; ks < 8; ++ks) af[ks] = *(const bf16x8*)(Arow + 32 * ks);
        const bf16_t* Brow = WendT + ((size_t)g * 128 + fr) * 256 + fq * 8;
#pragma unroll
        for (int nt = 0; nt < 8; ++nt) {
            f32x4 acc = (f32x4){0.f, 0.f, 0.f, 0.f};
#pragma unroll
            for (int ks = 0; ks < 8; ++ks) { const bf16x8 bfr = *(const bf16x8*)(Brow + nt * 4096 + ks * 32); acc = __builtin_amdgcn_mfma_f32_16x16x32_bf16(af[ks], bfr, acc, 0, 0, 0); }
#pragma unroll
            for (int r = 0; r < 4; ++r) L[(wave * 16 + 4 * fq + r) * 128 + nt * 16 + fr] = acc[r];
        }
        __syncthreads();
        if (tid < 64) {
            const float ar = A16[(g * 64 + tid) * 2], ai = A16[(g * 64 + tid) * 2 + 1];
            float sr = 0.f, si = 0.f;
            bf16_t* dst = Ag + ((size_t)g * NCH + b * 128) * KE + 256 + tid;
#pragma unroll 8
            for (int m = 0; m < 128; ++m) {
                dst[(size_t)m * KE] = f2bf(sr); dst[(size_t)m * KE + 64] = f2bf(si);
                const float lr = L[m * 128 + tid], li = L[m * 128 + 64 + tid];
                const float nr = ar * sr - ai * si + lr, ni = ar * si + ai * sr + li; sr = nr; si = ni;
            }
        }
        __syncthreads();
    }
}

__device__ __forceinline__ void sgu_phase(const MArgs& a, LAS unsigned char* lds, int G, int bx, int tid, int wave, int lane) {
    unsigned char* ws = a.ws;
    const bf16_t* gu = (const bf16_t*)((unsigned char*)a.out + 16 * MiB); const bf16_t* gv = (const bf16_t*)((unsigned char*)a.out + 32 * MiB); bf16_t* sgu = (bf16_t*)((unsigned char*)a.out + 48 * MiB);
    const bf16_t* Wm = (const bf16_t*)(ws + WS_WM); const float* b_s = a.in[18]; const float* gam = a.in[15]; const float* bet = a.in[16];
    const int fr = lane & 15, fq = lane >> 4;
    LAS float* st = (LAS float*)lds;
    LAS unsigned char* vTl = lds + 1024;
#pragma unroll 1
    for (int unit = bx; unit < T / SGB; unit += G) {
        const int t0 = unit * SGB;
#pragma unroll 1
        for (int i = 0; i < 16; ++i) {
            const int s = wave * 16 + i;
            const u32x4 rv = *(const u32x4*)(gv + (size_t)(t0 + s) * 512 + lane * 8);
            const f32x4 v0 = unpk_lo(rv), v1 = unpk_hi(rv);
            const float mu = wave_sum((v0[0] + v0[1]) + (v0[2] + v0[3]) + (v1[0] + v1[1]) + (v1[2] + v1[3])) * (1.f / 512.f);
            const f32x4 d0 = v0 - mu, d1 = v1 - mu;
            const float var = wave_sum((d0[0] * d0[0] + d0[1] * d0[1]) + (d0[2] * d0[2] + d0[3] * d0[3]) + (d1[0] * d1[0] + d1[1] * d1[1]) + (d1[2] * d1[2] + d1[3] * d1[3])) * (1.f / 512.f);
            if (lane == 0) { st[s * 2] = mu; st[s * 2 + 1] = rsqrtf(var + EPS); }
        }
        __syncthreads();
#pragma unroll 1
        for (int g = 0; g < SGG; ++g) {
#pragma unroll
            for (int i = 0; i < 4; ++i) {
                const int id = i * 512 + tid, s = id & 127, dc = id >> 7, ch = g * 128 + dc * 8;
                const u32x4 rv = *(const u32x4*)(gv + (size_t)(t0 + s) * 512 + ch);
                const float mu = st[s * 2], rs = st[s * 2 + 1];
                const f32x4 g0 = *(const f32x4*)(gam + ch), g1 = *(const f32x4*)(gam + ch + 4), b0 = *(const f32x4*)(bet + ch), b1 = *(const f32x4*)(bet + ch + 4);
                const f32x4 o0 = (unpk_lo(rv) - mu) * rs * g0 + b0, o1 = (unpk_hi(rv) - mu) * rs * g1 + b1;
                LAS bf16_t* dp = (LAS bf16_t*)(vTl + (dc * 8) * 272 + s * 2);
                dp[0 * 136] = f2bf(o0[0]); dp[1 * 136] = f2bf(o0[1]); dp[2 * 136] = f2bf(o0[2]); dp[3 * 136] = f2bf(o0[3]);
                dp[4 * 136] = f2bf(o1[0]); dp[5 * 136] = f2bf(o1[1]); dp[6 * 136] = f2bf(o1[2]); dp[7 * 136] = f2bf(o1[3]);
            }
            __syncthreads();
            f32x4 acc[8];
#pragma unroll
            for (int nt = 0; nt < 8; ++nt) acc[nt] = (f32x4){0.f, 0.f, 0.f, 0.f};
            const int ksmax = (wave * 16 + 15) >> 5;
            const bf16_t* Wrow = Wm + ((size_t)(g * 128 + wave * 16 + fr)) * 128 + fq * 8;
#pragma unroll 1
            for (int ks = 0; ks <= ksmax; ++ks) {
                const bf16x8 wf = *(const bf16x8*)(Wrow + ks * 32);
#pragma unroll
                for (int nt = 0; nt < 8; ++nt) { const bf16x8 vf = *(const LAS bf16x8*)(vTl + (nt * 16 + fr) * 272 + (ks * 32 + fq * 8) * 2); acc[nt] = __builtin_amdgcn_mfma_f32_16x16x32_bf16(vf, wf, acc[nt], 0, 0, 0); }
            }
            const int t = wave * 16 + fr; const float bias = b_s[g * 128 + t];
            const size_t ro = (size_t)(t0 + t) * 512 + g * 128 + 4 * fq;
#pragma unroll
            for (int nt = 0; nt < 8; ++nt) {
                const u32x2 uv = *(const u32x2*)(gu + ro + nt * 16);
                const float u0 = __uint_as_float(uv.x << 16), u1 = __uint_as_float(uv.x & 0xffff0000u), u2 = __uint_as_float(uv.y << 16), u3 = __uint_as_float(uv.y & 0xffff0000u);
                u32x2 w; w.x = cvtpk(u0 * (acc[nt][0] + bias), u1 * (acc[nt][1] + bias)); w.y = cvtpk(u2 * (acc[nt][2] + bias), u3 * (acc[nt][3] + bias));
                *(u32x2*)(sgu + ro + nt * 16) = w;
            }
            __syncthreads();
        }
    }
}

constexpr int AT_KROW = 272, AT_VROW = 528, AT_VOFF = 256 * AT_KROW;
__device__ __forceinline__ void attn_phase(const MArgs& a, LAS unsigned char* lds, int G, int bx, int tid, int wave, int lane) {
    unsigned char* ws = a.ws;
    const bf16_t* q = (const bf16_t*)((unsigned char*)a.out); const bf16_t* kb = (const bf16_t*)(ws + WS_KB); const bf16_t* vT = (const bf16_t*)(ws + WS_VT); bf16_t* ob = (bf16_t*)(ws + WS_R6);
    const int fr = lane & 15, fq = lane >> 4;
    LAS unsigned char* Ks = lds; LAS unsigned char* Vs = lds + AT_VOFF;
#pragma unroll 1
    for (int unit = bx; unit < NB * XH * 8; unit += G) {
        const int b = unit >> 5, hh = (unit >> 3) & 3, qb = unit & 7, t0 = b * SEQ + qb * 256;
#pragma unroll
        for (int i = 0; i < 8; ++i) { const int id = i * 512 + tid, row = id >> 4, ch = id & 15;
            *(LAS u32x4*)(Ks + row * AT_KROW + ch * 16) = *(const u32x4*)(kb + (size_t)(b * 256 + row) * 512 + hh * 128 + ch * 8); }
#pragma unroll
        for (int i = 0; i < 8; ++i) { const int id = i * 512 + tid, row = id >> 5, ch = id & 31;
            *(LAS u32x4*)(Vs + row * AT_VROW + ch * 16) = *(const u32x4*)(vT + ((size_t)(b * 4 + hh) * 128 + row) * 256 + ch * 8); }
        __syncthreads();
#pragma unroll 1
        for (int mt = 0; mt < 2; ++mt) {
            const int trow = t0 + wave * 32 + mt * 16 + fr;
            bf16x8 qf[4];
#pragma unroll
            for (int ks = 0; ks < 4; ++ks) qf[ks] = *(const bf16x8*)(q + (size_t)trow * 512 + hh * 128 + ks * 32 + fq * 8);
            f32x4 s[16];
#pragma unroll
            for (int nt = 0; nt < 16; ++nt) { s[nt] = (f32x4){0.f, 0.f, 0.f, 0.f};
#pragma unroll
                for (int ks = 0; ks < 4; ++ks) { const bf16x8 kf = *(const LAS bf16x8*)(Ks + (nt * 16 + fr) * AT_KROW + (ks * 32 + fq * 8) * 2); s[nt] = __builtin_amdgcn_mfma_f32_16x16x32_bf16(kf, qf[ks], s[nt], 0, 0, 0); }
                if (nt & 1) __builtin_amdgcn_sched_barrier(0); }
            float mx = s[0][0];
#pragma unroll
            for (int nt = 0; nt < 16; ++nt) mx = fmaxf(fmaxf(mx, fmaxf(s[nt][0], s[nt][1])), fmaxf(s[nt][2], s[nt][3]));
            mx = fmaxf(mx, __shfl_xor(mx, 16)); mx = fmaxf(mx, __shfl_xor(mx, 32));
            const float mneg = -mx * 1.4426950408889634f; float l = 0.f;
#pragma unroll
            for (int nt = 0; nt < 16; ++nt)
#pragma unroll
                for (int r = 0; r < 4; ++r) { const float p = __builtin_amdgcn_exp2f(__builtin_fmaf(s[nt][r], 1.4426950408889634f, mneg)); s[nt][r] = p; l += p; }
            l += __shfl_xor(l, 16); l += __shfl_xor(l, 32);
            bf16x8 pf[8];
#pragma unroll
            for (int k2 = 0; k2 < 8; ++k2) { const u32x4 w = pack8(s[2 * k2], s[2 * k2 + 1]); pf[k2] = __builtin_bit_cast(bf16x8, w); }
            const float rl = 1.f / l;
            bf16_t* orow = ob + (size_t)trow * 512 + hh * 128 + 4 * fq;
#pragma unroll
            for (int dt = 0; dt < 8; ++dt) {
                f32x4 o = (f32x4){0.f, 0.f, 0.f, 0.f};
#pragma unroll
                for (int k2 = 0; k2 < 8; ++k2) {
                    const LAS unsigned char* vp = Vs + (dt * 16 + fr) * AT_VROW + (k2 * 32 + fq * 4) * 2;
                    const u32x2 lo = *(const LAS u32x2*)vp, hi = *(const LAS u32x2*)(vp + 32);
                    const u32x4 vv = (u32x4){lo.x, lo.y, hi.x, hi.y};
                    o = __builtin_amdgcn_mfma_f32_16x16x32_bf16(__builtin_bit_cast(bf16x8, vv), pf[k2], o, 0, 0, 0);
                }
                u32x2 w; w.x = cvtpk(o[0] * rl, o[1] * rl); w.y = cvtpk(o[2] * rl, o[3] * rl);
                *(u32x2*)(orow + dt * 16) = w;
                __builtin_amdgcn_sched_barrier(0);
            }
        }
        __syncthreads();
    }
}

#ifndef PH_EN
#define PH_EN W_ALL
#endif
__global__ void __launch_bounds__(NTHREADS, 2) mega_fwd(MArgs a) {
    extern __shared__ __attribute__((aligned(16))) unsigned char lds_raw[];
    LAS unsigned char* lds = (LAS unsigned char*)lds_raw;
    const int tid = threadIdx.x, lane = tid & 63, wave = __builtin_amdgcn_readfirstlane(tid >> 6);
    const int G = gridDim.x, bx = blockIdx.x, mask = a.mask;
    unsigned char* ws = a.ws;
    for (int u = tid; u < (LDS_BYTES - LDSCTL_OFF) / 4; u += NTHREADS) ((LAS unsigned*)(lds + LDSCTL_OFF))[u] = 0u;
    __syncthreads();
    XcdBarrier bar; bar.bar = (unsigned*)(ws + WS_CTL) + CW_BAR; bar.x = 0; bar.st = nullptr;
    if (a.bars) bar = xcd_barrier_post((unsigned*)(ws + WS_CTL) + CW_BAR, (volatile LAS unsigned*)(lds + LDSCTL_OFF) + 8);
#define GRID_BAR(k) do { if (a.bars & (1 << (k))) xcd_barrier(bar); } while (0)
#define P_BF(off) ((bf16_t*)(ws + (off)))
#define WinT P_BF(WS_WIN)
#define WguT P_BF(WS_WGU)
#define WdT P_BF(WS_WD)
#define WkvT P_BF(WS_WKV)
#define WoutT P_BF(WS_WOUT)
#define WaT P_BF(WS_WA)
#define WbT P_BF(WS_WB)
#define WcT P_BF(WS_WC)
#define WgluT P_BF(WS_WGLU)
#define KmatT P_BF(WS_KMAT)
#define memn P_BF(WS_MEMN)
#define kb P_BF(WS_KB)
#define vT P_BF(WS_VT)
#define h P_BF(WS_R1)
#define yap P_BF(WS_R1)
#define merged P_BF(WS_R1)
#define Ag P_BF(WS_R2)
#define yag P_BF(WS_R2)
#define x1b P_BF(WS_R2)
#define ob P_BF(WS_R6)
#define gates P_BF(WS_R7)
#define act P_BF(WS_R7)
#define q ((bf16_t*)((unsigned char*)a.out))
#define gu ((bf16_t*)((unsigned char*)a.out + 16 * MiB))
#define gv ((bf16_t*)((unsigned char*)a.out + 32 * MiB))
#define sgu ((bf16_t*)((unsigned char*)a.out + 48 * MiB))
#define ss1 ((float*)(ws + WS_CTL + CTL_SS1))
#define ss2 ((float*)(ws + WS_CTL + CTL_SS2))
    if ((PH_EN & W_PREP) && (mask & W_PREP)) prep_phase(a, lds, G, bx, tid, wave, lane);
    GRID_BAR(0);
    if ((PH_EN & W_INPROJ) && (mask & W_INPROJ)) { TileOrder S; S.init(T, INW, G, bx, h, D, WinT, D); EpiInprojM E{Ag, gu, gv, q, gates, a.in[4]}; gemm_phase(lds, D, D, D / BK, S, E); }
    GRID_BAR(1);
    if ((PH_EN & W_S5L) && (mask & W_S5L)) s5l_phase(a, lds, G, bx, tid, wave, lane);
    if ((PH_EN & W_KV) && (mask & W_KV)) { KvOrder S{G, bx, (const char*)memn, (const char*)WkvT}; EpiKVM E{kb, vT}; gemm_phase(lds, D, D, D / BK, S, E); }
    if ((PH_EN & W_SGU) && (mask & W_SGU)) sgu_phase(a, lds, G, bx, tid, wave, lane);
    GRID_BAR(2);
    if ((PH_EN & W_S5Y) && (mask & W_S5Y)) { S5YOrder S{G, bx, (const char*)Ag, (const char*)KmatT}; EpiS5YM E{yap}; gemm_phase(lds, KE, KE, KE / BK, S, E); }
    if ((PH_EN & W_ATTN) && (mask & W_ATTN)) attn_phase(a, lds, G, bx, tid, wave, lane);
    GRID_BAR(3);
    if ((PH_EN & W_GLU) && (mask & W_GLU)) { TileOrder S; S.init(T, 512, G, bx, yap, 512, WgluT, 512); EpiGluM E{yap, a.in[14], yag}; gemm_phase(lds, 512, 512, 512 / BK, S, E); }
    GRID_BAR(4);
    if ((PH_EN & W_MERGE) && (mask & W_MERGE)) { MergeOrder S; S.T.init(T, D, G, bx, nullptr, 512, nullptr, 512); S.a0 = (const char*)yag; S.da1 = (const char*)sgu - (const char*)yag; S.da2 = (const char*)ob - (const char*)yag;
        S.b0 = (const char*)WaT; S.db1 = (const char*)WbT - (const char*)WaT; S.db2 = (const char*)WcT - (const char*)WaT; S.ta = (size_t)BM * 512 * 2; S.tb = (size_t)BM * 512 * 2;
        EpiMergeM E{gates, merged}; gemm_phase(lds, 512, 512, 512 / BK, S, E); }
    GRID_BAR(5);
    if ((PH_EN & W_WOUT) && (mask & W_WOUT)) { TileOrder S; S.init(T, D, G, bx, merged, D, WoutT, D); EpiResM E{a.in[0], a.out, x1b, ss1}; gemm_phase(lds, D, D, D / BK, S, E); }
    GRID_BAR(6);
    if ((PH_EN & W_FFNUP) && (mask & W_FFNUP)) { TileOrder S; S.init(T, NGU, G, bx, x1b, D, WguT, D); EpiFfnUpM E{ss1, act}; gemm_phase(lds, D, D, D / BK, S, E); }
    GRID_BAR(7);
    if ((PH_EN & W_FFNDOWN) && (mask & W_FFNDOWN)) { TileOrder S; S.init(T, D, G, bx, act, DFF, WdT, DFF); EpiResM E{a.out, a.out, nullptr, ss2}; gemm_phase(lds, DFF, DFF, DFF / BK, S, E); }
    GRID_BAR(8);
    if ((PH_EN & W_FINAL) && (mask & W_FINAL)) {
        const int gw = bx * NWAVES + wave, NGW = G * NWAVES; const float* gf = a.in[29];
        for (int r = gw; r < T; r += NGW) { f32x4* xr = (f32x4*)(a.out + (size_t)r * D) + lane; const float rs = rsqrtf(ss2[r] * (1.f / D) + EPS);
#pragma unroll
            for (int j = 0; j < 4; ++j) { const f32x4 gg = ((const f32x4*)gf)[64 * j + lane]; xr[64 * j] = xr[64 * j] * rs * gg; } }
    }
#undef GRID_BAR
#undef WinT
#undef WguT
#undef WdT
#undef WkvT
#undef WoutT
#undef WaT
#undef WbT
#undef WcT
#undef WgluT
#undef KmatT
#undef memn
#undef kb
#undef vT
#undef h
#undef yap
#undef merged
#undef Ag
#undef yag
#undef x1b
#undef ob
#undef gates
#undef act
#undef q
#undef gu
#undef gv
#undef sgu
#undef ss1
#undef ss2
}

#ifndef MEGA_STAGES
#define MEGA_STAGES 0
#endif
#ifndef ONE_LAUNCH
#define ONE_LAUNCH 0
#endif
extern "C" void kernel_launch(void* const* d_in, const int* in_sizes, int n_in, void* d_out, int out_size, void* d_ws, size_t ws_size, hipStream_t stream) {
    static int grid = 0;
    if (grid == 0) {
        if (n_in != 30 || out_size != T * D || ws_size < WS_END) { fprintf(stderr, "kernel_launch: unexpected sizes n_in %d out %d ws %zu\n", n_in, out_size, ws_size); grid = -1; return; }
        int dev = 0, cus = 0, per_cu = 0;
        if (hipGetDevice(&dev) != hipSuccess || hipDeviceGetAttribute(&cus, hipDeviceAttributeMultiprocessorCount, dev) != hipSuccess) { grid = -1; return; }
        if (hipFuncSetAttribute((const void*)mega_fwd, hipFuncAttributeMaxDynamicSharedMemorySize, LDS_BYTES) != hipSuccess) { fprintf(stderr, "kernel_launch: hipFuncSetAttribute failed\n"); grid = -1; return; }
        if (hipOccupancyMaxActiveBlocksPerMultiprocessor(&per_cu, (const void*)mega_fwd, NTHREADS, LDS_BYTES) != hipSuccess || per_cu < 1) { fprintf(stderr, "kernel_launch: occupancy query says %d blocks/CU\n", per_cu); (void)hipGetLastError(); }
        grid = cus;
    }
    if (grid < 0) return;
    const float* x = (const float*)d_in[0]; const float* mem = (const float*)d_in[1]; const float* g_mix = (const float*)d_in[2]; const float* w_in = (const float*)d_in[3];
    const float* b_gate = (const float*)d_in[4]; const float* a_re = (const float*)d_in[5]; const float* a_im = (const float*)d_in[6]; const float* log_dt = (const float*)d_in[7];
    const float* bm_re = (const float*)d_in[8]; const float* bm_im = (const float*)d_in[9]; const float* cm_re = (const float*)d_in[10]; const float* cm_im = (const float*)d_in[11];
    const float* d_skip = (const float*)d_in[12]; const float* w_glu = (const float*)d_in[13]; const float* b_glu = (const float*)d_in[14]; const float* g_sgu = (const float*)d_in[15];
    const float* beta_sgu = (const float*)d_in[16]; const float* w_s = (const float*)d_in[17]; const float* b_s = (const float*)d_in[18]; const float* g_mem = (const float*)d_in[19];
    const float* w_kv = (const float*)d_in[20]; const float* w_a = (const float*)d_in[21]; const float* w_b = (const float*)d_in[22]; const float* w_c = (const float*)d_in[23];
    const float* w_out = (const float*)d_in[24]; const float* g_ffn = (const float*)d_in[25]; const float* w_gate = (const float*)d_in[26]; const float* w_up = (const float*)d_in[27];
    const float* w_down = (const float*)d_in[28]; const float* g_final = (const float*)d_in[29];
    unsigned char* ws = (unsigned char*)d_ws; float* out = (float*)d_out;
    bf16_t* WinT = (bf16_t*)(ws + WS_WIN); bf16_t* WguT = (bf16_t*)(ws + WS_WGU); bf16_t* WdT = (bf16_t*)(ws + WS_WD); bf16_t* WkvT = (bf16_t*)(ws + WS_WKV); bf16_t* WoutT = (bf16_t*)(ws + WS_WOUT);
    bf16_t* WaT = (bf16_t*)(ws + WS_WA); bf16_t* WbT = (bf16_t*)(ws + WS_WB); bf16_t* WcT = (bf16_t*)(ws + WS_WC); bf16_t* WgluT = (bf16_t*)(ws + WS_WGLU);
    bf16_t* KmatT = (bf16_t*)(ws + WS_KMAT); bf16_t* WendT = (bf16_t*)(ws + WS_WEND); bf16_t* Wm = (bf16_t*)(ws + WS_WM); float* tabE = (float*)(ws + WS_TABE); float* tabB = (float*)(ws + WS_TABB);
    float* sgst = (float*)(ws + WS_SGST); bf16_t* memn = (bf16_t*)(ws + WS_MEMN); bf16_t* kb = (bf16_t*)(ws + WS_KB); bf16_t* vT = (bf16_t*)(ws + WS_VT);
    bf16_t* h = (bf16_t*)(ws + WS_R1); bf16_t* yap = (bf16_t*)(ws + WS_R1); bf16_t* merged = (bf16_t*)(ws + WS_R1);
    bf16_t* Ag = (bf16_t*)(ws + WS_R2); bf16_t* yag = (bf16_t*)(ws + WS_R2); bf16_t* x1b = (bf16_t*)(ws + WS_R2); bf16_t* ob = (bf16_t*)(ws + WS_R6);
    bf16_t* gates = (bf16_t*)(ws + WS_R7); bf16_t* act = (bf16_t*)(ws + WS_R7);
    bf16_t* q = (bf16_t*)((unsigned char*)d_out); bf16_t* gu = (bf16_t*)((unsigned char*)d_out + 16 * MiB); bf16_t* gv = (bf16_t*)((unsigned char*)d_out + 32 * MiB); bf16_t* sgu = (bf16_t*)((unsigned char*)d_out + 48 * MiB);
    float* ss1 = (float*)(ws + WS_CTL + CTL_SS1); float* ss2 = (float*)(ws + WS_CTL + CTL_SS2);
    (void)tabE; (void)tabB; (void)KmatT; (void)WendT;

    MArgs ma{};
    for (int i = 0; i < 30; ++i) ma.in[i] = (const float*)d_in[i];
    ma.out = out; ma.ws = ws;
    (void)hipMemsetAsync(ws + WS_CTL, 0, 1 * MiB, stream);
#define MEGA(m, b) do { ma.mask = (m); ma.bars = (b); hipLaunchKernelGGL(mega_fwd, dim3(grid), dim3(NTHREADS), LDS_BYTES, stream, ma); } while (0)
#define ISM(w) ((MEGA_STAGES) & (w))
    if (ONE_LAUNCH) { MEGA(W_ALL, 0x1ff); return; }
    if (ISM(W_PREP)) MEGA(W_PREP, 0);
    else {
        k_tconv<<<dim3(INW / 64, D / 64), 512, 0, stream>>>(w_in, D, INW, WinT, D, nullptr, 0, 0);
        k_tconv<<<dim3(DFF / 64, D / 64), 512, 0, stream>>>(w_gate, D, DFF, WguT, D, g_ffn, 1, 0);
        k_tconv<<<dim3(DFF / 64, D / 64), 512, 0, stream>>>(w_up, D, DFF, WguT, D, g_ffn, 2, 0);
        k_tconv<<<dim3(D / 64, DFF / 64), 512, 0, stream>>>(w_down, DFF, D, WdT, DFF, nullptr, 0, 0);
        k_tconv<<<dim3(1024 / 64, D / 64), 512, 0, stream>>>(w_kv, D, 1024, WkvT, D, nullptr, 0, 0);
        k_tconv<<<dim3(D / 64, D / 64), 512, 0, stream>>>(w_out, D, D, WoutT, D, nullptr, 0, 0);
        k_tconv<<<dim3(D / 64, 512 / 64), 512, 0, stream>>>(w_a, 512, D, WaT, 512, nullptr, 0, 0);
        k_tconv<<<dim3(D / 64, 512 / 64), 512, 0, stream>>>(w_b, 512, D, WbT, 512, nullptr, 0, 0);
        k_tconv<<<dim3(D / 64, 512 / 64), 512, 0, stream>>>(w_c, 512, D, WcT, 512, nullptr, 0, 0);
        k_tconv<<<dim3(512 / 64, 512 / 64), 512, 0, stream>>>(w_glu, 512, 512, WgluT, 512, nullptr, 0, 0);
        k_rmsrows<<<T / 8, 512, 0, stream>>>(x, g_mix, h, T);
        k_rmsrows<<<TM / 8, 512, 0, stream>>>(mem, g_mem, memn, TM);
        k_s5tab<<<(S5G * S5P + 255) / 256, 256, 0, stream>>>(a_re, a_im, log_dt, bm_re, bm_im, tabE, tabB);
        k_s5mats<<<dim3((256 * KE + 128 * 256) / 256, S5G), 256, 0, stream>>>(tabE, tabB, cm_re, cm_im, d_skip, KmatT, WendT);
        k_wm<<<(SGG * SGB * SGB + 255) / 256, 256, 0, stream>>>(w_s, Wm);
    }
    if (ISM(W_INPROJ)) MEGA(W_INPROJ, 0); else k_ngemm<EpiInproj><<<dim3(INW / 64, T / 4), 256, 0, stream>>>(h, D, WinT, D, D, EpiInproj{Ag, gu, gv, q, gates, b_gate});
    if (ISM(W_KV)) MEGA(W_KV, 0); else k_ngemm<EpiKV><<<dim3(1024 / 64, TM / 4), 256, 0, stream>>>(memn, D, WkvT, D, D, EpiKV{kb, vT});
    if (ISM(W_S5L)) { MEGA(W_S5L, 0); MEGA(W_S5Y, 0); } else k_s5_naive<<<NB * S5G, 64, 0, stream>>>(Ag, a_re, a_im, log_dt, bm_re, bm_im, cm_re, cm_im, d_skip, yap);
    if (ISM(W_ATTN)) MEGA(W_ATTN, 0); else k_attn_naive<<<T * XH, 256, 0, stream>>>(q, kb, vT, ob);
    if (ISM(W_SGU)) MEGA(W_SGU, 0);
    else { k_sgu_stats<<<T / 8, 512, 0, stream>>>(gv, sgst); k_sgu_naive<<<dim3(2, T), 256, 0, stream>>>(gu, gv, sgst, Wm, b_s, g_sgu, beta_sgu, sgu); }
    if (ISM(W_GLU)) MEGA(W_GLU, 0); else k_ngemm<EpiGlu><<<dim3(512 / 64, T / 4), 256, 0, stream>>>(yap, 512, WgluT, 512, 512, EpiGlu{yap, b_glu, yag});
    if (ISM(W_MERGE)) MEGA(W_MERGE, 0); else k_merge_naive<<<dim3(D / 64, T / 4), 256, 0, stream>>>(yag, sgu, ob, WaT, WbT, WcT, gates, merged);
    if (ISM(W_WOUT)) MEGA(W_WOUT, 0);
    else { k_ngemm<EpiWout><<<dim3(D / 64, T / 4), 256, 0, stream>>>(merged, D, WoutT, D, D, EpiWout{x, out, x1b}); k_rowss<<<T / 8, 512, 0, stream>>>(out, ss1); }
    if (ISM(W_FFNUP)) MEGA(W_FFNUP, 0); else k_ffnup_naive<<<dim3(DFF / 64, T / 4), 256, 0, stream>>>(x1b, WguT, ss1, act);
    if (ISM(W_FFNDOWN)) MEGA(W_FFNDOWN, 0);
    else { k_ngemm<EpiDown><<<dim3(D / 64, T / 4), 256, 0, stream>>>(act, DFF, WdT, DFF, DFF, EpiDown{out}); k_rowss<<<T / 8, 512, 0, stream>>>(out, ss2); }
    if (ISM(W_FINAL)) MEGA(W_FINAL, 0); else k_final<<<T * D / 4 / 256, 256, 0, stream>>>(out, ss2, g_final);
}
```

```cpp
#define MEGA_STAGES (W_ALL)
#define ONE_LAUNCH 1
#include <hip/hip_runtime.h>
#include <cstdio>
#include <cstdint>

typedef unsigned short bf16_t;
constexpr int NB = 8, SEQ = 2048, D = 1024, T = NB * SEQ, MEML = 256, TM = NB * MEML;
constexpr int S5W = 512, S5G = 32, S5H = 16, S5P = 64, LC = 16, NCH = T / LC, KE = LC * S5H + 2 * S5P;
constexpr int SGW = 512, SGG = 4, SGD = 128, SGB = 128;
constexpr int XH = 4, XD = 128, XW = 512;
constexpr int DFF = 2816, INW = 5120, NGU = 2 * DFF;
constexpr float EPS = 1e-6f;
constexpr size_t MiB = 1u << 20;
constexpr size_t WS_CTL = 0;
constexpr size_t CTL_SS1 = 256 * 1024, CTL_SS2 = 384 * 1024;
constexpr size_t WS_WIN = 1 * MiB, WS_WGU = 11 * MiB, WS_WD = 22 * MiB, WS_WKV = 28 * MiB, WS_WOUT = 30 * MiB;
constexpr size_t WS_WA = 32 * MiB, WS_WB = 33 * MiB, WS_WC = 34 * MiB, WS_WGLU = 35 * MiB, WS_KMAT = 36 * MiB, WS_WEND = 42 * MiB;
constexpr size_t WS_WM = 44 * MiB, WS_TABE = 44 * MiB + 256 * 1024, WS_TABB = 44 * MiB + 512 * 1024, WS_SGST = 45 * MiB;
constexpr size_t WS_MEMN = 46 * MiB, WS_KB = 50 * MiB, WS_VT = 52 * MiB;
constexpr size_t WS_R1 = 56 * MiB;
constexpr size_t WS_R2 = 88 * MiB;
constexpr size_t WS_R6 = 112 * MiB;
constexpr size_t WS_R7 = 128 * MiB;
constexpr size_t WS_END = 224 * MiB;

__device__ __forceinline__ float bf2f(bf16_t v) { return __uint_as_float((unsigned)v << 16); }
__device__ __forceinline__ bf16_t f2bf(float f) { unsigned u = __float_as_uint(f); return (bf16_t)((u + 0x7fffu + ((u >> 16) & 1u)) >> 16); }
__device__ __forceinline__ float gelu_t(float x) { const float u = 0.7978845608028654f * (x + 0.044715f * x * x * x); return 0.5f * x * (1.f + tanhf(u)); }
__device__ __forceinline__ float sigm(float x) { return 1.f / (1.f + expf(-x)); }
__device__ __forceinline__ float wave_sum(float v) {
#pragma unroll
    for (int o = 1; o < 64; o <<= 1) v += __shfl_xor(v, o);
    return v;
}
__device__ __forceinline__ float wave_max(float v) {
#pragma unroll
    for (int o = 1; o < 64; o <<= 1) v = fmaxf(v, __shfl_xor(v, o));
    return v;
}
__device__ __forceinline__ float dot8(uint4 a, uint4 b) {
    float s = 0.f;
    s += __uint_as_float(a.x << 16) * __uint_as_float(b.x << 16) + __uint_as_float(a.x & 0xffff0000u) * __uint_as_float(b.x & 0xffff0000u);
    s += __uint_as_float(a.y << 16) * __uint_as_float(b.y << 16) + __uint_as_float(a.y & 0xffff0000u) * __uint_as_float(b.y & 0xffff0000u);
    s += __uint_as_float(a.z << 16) * __uint_as_float(b.z << 16) + __uint_as_float(a.z & 0xffff0000u) * __uint_as_float(b.z & 0xffff0000u);
    s += __uint_as_float(a.w << 16) * __uint_as_float(b.w << 16) + __uint_as_float(a.w & 0xffff0000u) * __uint_as_float(b.w & 0xffff0000u);
    return s;
}
__device__ __forceinline__ float dotrow(const bf16_t* a, const bf16_t* b, int K) {
    float acc = 0.f;
    for (int k = 0; k < K; k += 8) acc += dot8(*(const uint4*)(a + k), *(const uint4*)(b + k));
    return acc;
}

__global__ void __launch_bounds__(512) k_tconv(const float* __restrict__ W, int K, int N, bf16_t* __restrict__ WT, int ldt, const float* __restrict__ scale, int mode, int row_off) {
    __shared__ float tile[64][65];
    const int n0 = blockIdx.x * 64, k0 = blockIdx.y * 64, tid = threadIdx.x;
#pragma unroll
    for (int i = 0; i < 8; ++i) { const int kk = i * 8 + (tid >> 6), nn = tid & 63; float v = W[(size_t)(k0 + kk) * N + n0 + nn]; if (scale) v *= scale[k0 + kk]; tile[kk][nn] = v; }
    __syncthreads();
    const int n = tid >> 3, kc = tid & 7, ng = n0 + n;
    int drow;
    if (mode == 0) drow = ng + row_off; else drow = 256 * (ng >> 7) + 128 * (mode - 1) + (ng & 127);
    uint4 o;
    o.x = (unsigned)f2bf(tile[kc * 8 + 0][n]) | ((unsigned)f2bf(tile[kc * 8 + 1][n]) << 16);
    o.y = (unsigned)f2bf(tile[kc * 8 + 2][n]) | ((unsigned)f2bf(tile[kc * 8 + 3][n]) << 16);
    o.z = (unsigned)f2bf(tile[kc * 8 + 4][n]) | ((unsigned)f2bf(tile[kc * 8 + 5][n]) << 16);
    o.w = (unsigned)f2bf(tile[kc * 8 + 6][n]) | ((unsigned)f2bf(tile[kc * 8 + 7][n]) << 16);
    *(uint4*)(WT + (size_t)drow * ldt + k0 + kc * 8) = o;
}
__global__ void __launch_bounds__(512) k_rmsrows(const float* __restrict__ x, const float* __restrict__ g, bf16_t* __restrict__ out, int rows) {
    const int row = blockIdx.x * 8 + (threadIdx.x >> 6), lane = threadIdx.x & 63;
    if (row >= rows) return;
    const float4* xr = (const float4*)(x + (size_t)row * D) + lane;
    float4 v[4]; float s = 0.f;
#pragma unroll
    for (int j = 0; j < 4; ++j) { v[j] = xr[64 * j]; s += v[j].x * v[j].x + v[j].y * v[j].y + v[j].z * v[j].z + v[j].w * v[j].w; }
    const float rs = rsqrtf(wave_sum(s) * (1.f / D) + EPS);
#pragma unroll
    for (int j = 0; j < 4; ++j) {
        const float4 gg = ((const float4*)g)[64 * j + lane];
        uint2 o; o.x = (unsigned)f2bf(v[j].x * rs * gg.x) | ((unsigned)f2bf(v[j].y * rs * gg.y) << 16); o.y = (unsigned)f2bf(v[j].z * rs * gg.z) | ((unsigned)f2bf(v[j].w * rs * gg.w) << 16);
        ((uint2*)(out + (size_t)row * D))[64 * j + lane] = o;
    }
}
__global__ void k_s5tab(const float* a_re, const float* a_im, const float* log_dt, const float* bm_re, const float* bm_im, float* tabE, float* tabB) {
    const int idx = blockIdx.x * blockDim.x + threadIdx.x; if (idx >= S5G * S5P) return;
    const int g = idx / S5P;
    const double dt = exp((double)log_dt[g]), ar = a_re[idx], ai = a_im[idx];
    const double mag = exp(ar * dt), th = ai * dt;
    const double abr = mag * cos(th), abi = mag * sin(th);
    const double nr = abr - 1.0, den = ar * ar + ai * ai;
    const double fre = (nr * ar + abi * ai) / den, fim = (abi * ar - nr * ai) / den;
    double er = 1.0, ei = 0.0;
    for (int t = 0; t <= LC; ++t) { tabE[(idx * 17 + t) * 2] = (float)er; tabE[(idx * 17 + t) * 2 + 1] = (float)ei; const double nr2 = er * abr - ei * abi, ni2 = er * abi + ei * abr; er = nr2; ei = ni2; }
    for (int h = 0; h < S5H; ++h) { const double br = bm_re[idx * S5H + h], bi = bm_im[idx * S5H + h]; tabB[(idx * 16 + h) * 2] = (float)(fre * br - fim * bi); tabB[(idx * 16 + h) * 2 + 1] = (float)(fre * bi + fim * br); }
}
__global__ void __launch_bounds__(256) k_s5mats(const float* __restrict__ tabE, const float* __restrict__ tabB, const float* __restrict__ cm_re, const float* __restrict__ cm_im, const float* __restrict__ d_skip, bf16_t* __restrict__ KmatT, bf16_t* __restrict__ WendT) {
    const int g = blockIdx.y;
    const int e = blockIdx.x * 256 + threadIdx.x;
    const float* E = tabE + (size_t)g * S5P * 17 * 2; const float* Bb = tabB + (size_t)g * S5P * 16 * 2;
    if (e < 256 * KE) {
        const int n = e / KE, k = e % KE, to = n >> 4, h = n & 15; float val = 0.f;
        if (k < 256) {
            const int ti = k >> 4, hp = k & 15;
            if (ti <= to) {
                const int tau = to - ti; float s = 0.f;
                for (int p = 0; p < S5P; ++p) {
                    const float cr = cm_re[(g * 16 + h) * 64 + p], ci = cm_im[(g * 16 + h) * 64 + p];
                    const float er = E[(p * 17 + tau) * 2], ei = E[(p * 17 + tau) * 2 + 1];
                    const float br = Bb[(p * 16 + hp) * 2], bi = Bb[(p * 16 + hp) * 2 + 1];
                    const float xr = er * br - ei * bi, xi = er * bi + ei * br;
                    s += cr * xr - ci * xi;
                }
                if (tau == 0 && hp == h) s += d_skip[g * 16 + h];
                val = s;
            }
        } else {
            const int pp = k - 256, p = pp & 63, im = pp >> 6;
            const float cr = cm_re[(g * 16 + h) * 64 + p], ci = cm_im[(g * 16 + h) * 64 + p];
            const float er = E[(p * 17 + to + 1) * 2], ei = E[(p * 17 + to + 1) * 2 + 1];
            val = im ? -(cr * ei + ci * er) : (cr * er - ci * ei);
        }
        KmatT[(size_t)g * 256 * KE + e] = f2bf(val);
    } else {
        const int e2 = e - 256 * KE; if (e2 >= 128 * 256) return;
        const int pp = e2 >> 8, k = e2 & 255, p = pp & 63, im = pp >> 6, tau = k >> 4, hp = k & 15;
        const float er = E[(p * 17 + (LC - 1 - tau)) * 2], ei = E[(p * 17 + (LC - 1 - tau)) * 2 + 1];
        const float br = Bb[(p * 16 + hp) * 2], bi = Bb[(p * 16 + hp) * 2 + 1];
        WendT[(size_t)g * 128 * 256 + e2] = f2bf(im ? (er * bi + ei * br) : (er * br - ei * bi));
    }
}
__global__ void k_wm(const float* __restrict__ w_s, bf16_t* __restrict__ Wm) {
    const int e = blockIdx.x * blockDim.x + threadIdx.x; if (e >= SGG * SGB * SGB) return;
    const int t = (e >> 7) & 127, s = e & 127; Wm[e] = (s <= t) ? f2bf(w_s[e]) : (bf16_t)0;
}

template <class Epi> __global__ void __launch_bounds__(256) k_ngemm(const bf16_t* __restrict__ A, int lda, const bf16_t* __restrict__ Bt, int ldb, int K, Epi e) {
    const int n = blockIdx.x * 64 + (threadIdx.x & 63), m = blockIdx.y * 4 + (threadIdx.x >> 6);
    e(m, n, dotrow(A + (size_t)m * lda, Bt + (size_t)n * ldb, K));
}
struct EpiInproj {
    bf16_t *Ag, *gu, *gv, *q, *gates; const float* b_gate;
    __device__ void operator()(int m, int n, float acc) const {
        if (n < 512) { const int g = n >> 4; Ag[((size_t)g * NCH + (m >> 4)) * KE + (m & 15) * 16 + (n & 15)] = f2bf(acc); }
        else if (n < 1024) gu[(size_t)m * 512 + n - 512] = f2bf(gelu_t(acc));
        else if (n < 1536) gv[(size_t)m * 512 + n - 1024] = f2bf(gelu_t(acc));
        else if (n < 2048) q[(size_t)m * 512 + n - 1536] = f2bf(acc * 0.08838834764831845f);
        else gates[(size_t)m * 3072 + n - 2048] = f2bf(sigm(acc + b_gate[n - 2048]));
    }
};
struct EpiKV {
    bf16_t *kb, *vT;
    __device__ void operator()(int m, int n, float acc) const {
        if (n < 512) kb[(size_t)m * 512 + n] = f2bf(acc);
        else { const int b = m >> 8, mm = m & 255, hd = n - 512; vT[((size_t)b * 512 + hd) * 256 + mm] = f2bf(acc); }
    }
};
struct EpiGlu {
    const bf16_t* yap; const float* b_glu; bf16_t* yag;
    __device__ void operator()(int m, int n, float acc) const { const float y = bf2f(yap[(size_t)m * 512 + n]); yag[(size_t)m * 512 + n] = f2bf(y * sigm(acc + b_glu[n])); }
};
struct EpiWout {
    const float* x; float* x1; bf16_t* x1b;
    __device__ void operator()(int m, int n, float acc) const { const float v = x[(size_t)m * D + n] + acc; x1[(size_t)m * D + n] = v; x1b[(size_t)m * D + n] = f2bf(v); }
};
struct EpiDown {
    float* x1;
    __device__ void operator()(int m, int n, float acc) const { x1[(size_t)m * D + n] += acc; }
};
__global__ void __launch_bounds__(64) k_s5_naive(const bf16_t* __restrict__ Ag, const float* a_re, const float* a_im, const float* log_dt, const float* bm_re, const float* bm_im,
                                                 const float* cm_re, const float* cm_im, const float* d_skip, bf16_t* __restrict__ yap) {
    const int b = blockIdx.x >> 5, g = blockIdx.x & 31, p = threadIdx.x;
    const float dt = expf(log_dt[g]), ar = a_re[g * 64 + p], ai = a_im[g * 64 + p];
    const float mag = expf(ar * dt), abr = mag * cosf(ai * dt), abi = mag * sinf(ai * dt);
    const float nr = abr - 1.f, den = ar * ar + ai * ai, fre = (nr * ar + abi * ai) / den, fim = (abi * ar - nr * ai) / den;
    float bbr[16], bbi[16], cr[16], ci[16];
#pragma unroll
    for (int h = 0; h < 16; ++h) {
        const float br = bm_re[(g * 64 + p) * 16 + h], bi = bm_im[(g * 64 + p) * 16 + h];
        bbr[h] = fre * br - fim * bi; bbi[h] = fre * bi + fim * br;
        cr[h] = cm_re[(g * 16 + h) * 64 + p]; ci[h] = cm_im[(g * 16 + h) * 64 + p];
    }
    const float dsk = d_skip[g * 16 + (p & 15)];
    float sr = 0.f, si = 0.f;
    for (int t = 0; t < SEQ; ++t) {
        const int tg = b * SEQ + t;
        const bf16_t* up = Ag + ((size_t)g * NCH + (tg >> 4)) * KE + (tg & 15) * 16;
        const uint4 u0 = *(const uint4*)up, u1 = *(const uint4*)(up + 8);
        float u[16];
        u[0] = __uint_as_float(u0.x << 16); u[1] = __uint_as_float(u0.x & 0xffff0000u); u[2] = __uint_as_float(u0.y << 16); u[3] = __uint_as_float(u0.y & 0xffff0000u);
        u[4] = __uint_as_float(u0.z << 16); u[5] = __uint_as_float(u0.z & 0xffff0000u); u[6] = __uint_as_float(u0.w << 16); u[7] = __uint_as_float(u0.w & 0xffff0000u);
        u[8] = __uint_as_float(u1.x << 16); u[9] = __uint_as_float(u1.x & 0xffff0000u); u[10] = __uint_as_float(u1.y << 16); u[11] = __uint_as_float(u1.y & 0xffff0000u);
        u[12] = __uint_as_float(u1.z << 16); u[13] = __uint_as_float(u1.z & 0xffff0000u); u[14] = __uint_as_float(u1.w << 16); u[15] = __uint_as_float(u1.w & 0xffff0000u);
        float bur = 0.f, bui = 0.f;
#pragma unroll
        for (int h = 0; h < 16; ++h) { bur += bbr[h] * u[h]; bui += bbi[h] * u[h]; }
        const float nsr = abr * sr - abi * si + bur, nsi = abr * si + abi * sr + bui; sr = nsr; si = nsi;
        float mine = 0.f, um = 0.f;
#pragma unroll
        for (int h = 0; h < 16; ++h) { const float y = wave_sum(cr[h] * sr - ci[h] * si); if (p == h) { mine = y; um = u[h]; } }
        if (p < 16) yap[(size_t)tg * 512 + g * 16 + p] = f2bf(gelu_t(mine + dsk * um));
    }
}
__global__ void __launch_bounds__(256) k_attn_naive(const bf16_t* __restrict__ q, const bf16_t* __restrict__ kb, const bf16_t* __restrict__ vT, bf16_t* __restrict__ o) {
    __shared__ float sc[256]; __shared__ float red[8];
    const int t = blockIdx.x >> 2, h = blockIdx.x & 3, b = t / SEQ, tid = threadIdx.x, lane = tid & 63, w = tid >> 6;
    const float s = dotrow(q + (size_t)t * 512 + h * 128, kb + (size_t)(b * 256 + tid) * 512 + h * 128, 128);
    float mx = wave_max(s); if (lane == 0) red[w] = mx; __syncthreads();
    mx = fmaxf(fmaxf(red[0], red[1]), fmaxf(red[2], red[3]));
    const float e = expf(s - mx); float sm = wave_sum(e); if (lane == 0) red[4 + w] = sm; __syncthreads();
    sm = red[4] + red[5] + red[6] + red[7];
    sc[tid] = e / sm; __syncthreads();
    if (tid < 128) {
        const bf16_t* vr = vT + ((size_t)b * 512 + h * 128 + tid) * 256; float acc = 0.f;
        for (int m = 0; m < 256; ++m) acc += sc[m] * bf2f(vr[m]);
        o[(size_t)t * 512 + h * 128 + tid] = f2bf(acc);
    }
}
__global__ void __launch_bounds__(512) k_sgu_stats(const bf16_t* __restrict__ gv, float* __restrict__ st) {
    const int row = blockIdx.x * 8 + (threadIdx.x >> 6), lane = threadIdx.x & 63;
    const uint4 r = ((const uint4*)(gv + (size_t)row * 512))[lane];
    float v[8]; v[0] = __uint_as_float(r.x << 16); v[1] = __uint_as_float(r.x & 0xffff0000u); v[2] = __uint_as_float(r.y << 16); v[3] = __uint_as_float(r.y & 0xffff0000u);
    v[4] = __uint_as_float(r.z << 16); v[5] = __uint_as_float(r.z & 0xffff0000u); v[6] = __uint_as_float(r.w << 16); v[7] = __uint_as_float(r.w & 0xffff0000u);
    float s = 0.f;
#pragma unroll
    for (int j = 0; j < 8; ++j) s += v[j];
    const float mu = wave_sum(s) * (1.f / 512.f); float q = 0.f;
#pragma unroll
    for (int j = 0; j < 8; ++j) { const float d = v[j] - mu; q += d * d; }
    const float rstd = rsqrtf(wave_sum(q) * (1.f / 512.f) + EPS);
    if (lane == 0) { st[row * 2] = mu; st[row * 2 + 1] = rstd; }
}
__global__ void __launch_bounds__(256) k_sgu_naive(const bf16_t* __restrict__ gu, const bf16_t* __restrict__ gv, const float* __restrict__ st, const bf16_t* __restrict__ Wm, const float* __restrict__ b_s,
                                                   const float* __restrict__ g_sgu, const float* __restrict__ beta, bf16_t* __restrict__ out) {
    const int c = blockIdx.x * 256 + threadIdx.x, t = blockIdx.y, tt = t & 127, t0 = t - tt, g = c >> 7;
    const float gam = g_sgu[c], bet = beta[c];
    float sv = b_s[g * 128 + tt];
    for (int s = 0; s <= tt; ++s) { const float v = (bf2f(gv[(size_t)(t0 + s) * 512 + c]) - st[(t0 + s) * 2]) * st[(t0 + s) * 2 + 1] * gam + bet; sv += bf2f(Wm[(g * 128 + tt) * 128 + s]) * v; }
    out[(size_t)t * 512 + c] = f2bf(bf2f(gu[(size_t)t * 512 + c]) * sv);
}
__global__ void __launch_bounds__(256) k_merge_naive(const bf16_t* __restrict__ yag, const bf16_t* __restrict__ sgu, const bf16_t* __restrict__ o, const bf16_t* __restrict__ WaT, const bf16_t* __restrict__ WbT,
                                                     const bf16_t* __restrict__ WcT, const bf16_t* __restrict__ gates, bf16_t* __restrict__ merged) {
    const int n = blockIdx.x * 64 + (threadIdx.x & 63), m = blockIdx.y * 4 + (threadIdx.x >> 6);
    const float ya = dotrow(yag + (size_t)m * 512, WaT + (size_t)n * 512, 512), yb = dotrow(sgu + (size_t)m * 512, WbT + (size_t)n * 512, 512), yc = dotrow(o + (size_t)m * 512, WcT + (size_t)n * 512, 512);
    const bf16_t* gr = gates + (size_t)m * 3072 + n;
    merged[(size_t)m * D + n] = f2bf(bf2f(gr[0]) * ya + bf2f(gr[1024]) * yb + bf2f(gr[2048]) * yc);
}
__global__ void __launch_bounds__(256) k_ffnup_naive(const bf16_t* __restrict__ x1b, const bf16_t* __restrict__ WguT, const float* __restrict__ ss1, bf16_t* __restrict__ act) {
    const int j = blockIdx.x * 64 + (threadIdx.x & 63), m = blockIdx.y * 4 + (threadIdx.x >> 6);
    const int r0 = 256 * (j >> 7) + (j & 127);
    const float G = dotrow(x1b + (size_t)m * D, WguT + (size_t)r0 * D, D), U = dotrow(x1b + (size_t)m * D, WguT + (size_t)(r0 + 128) * D, D);
    const float rs = rsqrtf(ss1[m] * (1.f / D) + EPS), gg = rs * G;
    act[(size_t)m * DFF + j] = f2bf(gg * sigm(gg) * (rs * U));
}
__global__ void __launch_bounds__(512) k_rowss(const float* __restrict__ x, float* __restrict__ ss) {
    const int row = blockIdx.x * 8 + (threadIdx.x >> 6), lane = threadIdx.x & 63;
    const float4* xr = (const float4*)(x + (size_t)row * D) + lane; float s = 0.f;
#pragma unroll
    for (int j = 0; j < 4; ++j) { const float4 v = xr[64 * j]; s += v.x * v.x + v.y * v.y + v.z * v.z + v.w * v.w; }
    s = wave_sum(s); if (lane == 0) ss[row] = s;
}
__global__ void __launch_bounds__(256) k_final(float* __restrict__ x, const float* __restrict__ ss, const float* __restrict__ g) {
    const size_t i = (size_t)blockIdx.x * 256 + threadIdx.x; const int row = (int)(i >> 8), c4 = (int)(i & 255);
    const float rs = rsqrtf(ss[row] * (1.f / D) + EPS);
    float4 v = ((float4*)x)[i]; const float4 gg = ((const float4*)g)[c4];
    v.x *= rs * gg.x; v.y *= rs * gg.y; v.z *= rs * gg.z; v.w *= rs * gg.w; ((float4*)x)[i] = v;
}

#define LAS __attribute__((address_space(3)))
typedef short bf16x8 __attribute__((ext_vector_type(8)));
typedef float f32x4 __attribute__((ext_vector_type(4)));
typedef float f32x2 __attribute__((ext_vector_type(2)));
typedef unsigned u32x4 __attribute__((ext_vector_type(4)));
typedef unsigned u32x2 __attribute__((ext_vector_type(2)));
typedef __bf16 bf16x2_t __attribute__((ext_vector_type(2)));

constexpr int NWAVES = 8, NTHREADS = 512;
constexpr int BM = 256, BK = 64, HALF = 128, HTB = HALF * BK * 2, NXCD = 8, WGM = 8;
constexpr int RING_BYTES = 131072, LDS_BYTES = 147456, LDSCTL_OFF = LDS_BYTES - 512;
constexpr int CW_BAR = 4096;
enum { W_PREP = 1, W_INPROJ = 2, W_KV = 4, W_S5L = 8, W_SGU = 16, W_S5Y = 32, W_ATTN = 64, W_GLU = 128, W_MERGE = 256, W_WOUT = 512, W_FFNUP = 1024, W_FFNDOWN = 2048, W_FINAL = 4096, W_ALL = 8191 };

#define LDS_WAIT() asm volatile("s_waitcnt lgkmcnt(0)" ::: "memory")
#define VM_WAIT() asm volatile("s_waitcnt vmcnt(0)" ::: "memory")
__device__ __forceinline__ unsigned cvtpk(float lo, float hi) { f32x2 v = {lo, hi}; bf16x2_t b = __builtin_convertvector(v, bf16x2_t); return __builtin_bit_cast(unsigned, b); }
__device__ __forceinline__ u32x4 pack8(const f32x4 a, const f32x4 b) { u32x4 w; w.x = cvtpk(a[0], a[1]); w.y = cvtpk(a[2], a[3]); w.z = cvtpk(b[0], b[1]); w.w = cvtpk(b[2], b[3]); return w; }
__device__ __forceinline__ f32x4 unpk_lo(const u32x4 w) { return (f32x4){__uint_as_float(w.x << 16), __uint_as_float(w.x & 0xffff0000u), __uint_as_float(w.y << 16), __uint_as_float(w.y & 0xffff0000u)}; }
__device__ __forceinline__ f32x4 unpk_hi(const u32x4 w) { return (f32x4){__uint_as_float(w.z << 16), __uint_as_float(w.z & 0xffff0000u), __uint_as_float(w.w << 16), __uint_as_float(w.w & 0xffff0000u)}; }
__device__ __forceinline__ float sigm_f(float x) { return __builtin_amdgcn_rcpf(1.f + __builtin_amdgcn_exp2f(-1.4426950408889634f * x)); }
__device__ __forceinline__ float gelu_f(float x) { const float u2 = 1.5957691216057308f * (x + 0.044715f * x * x * x); return x * sigm_f(u2); }
__device__ __forceinline__ f32x4 gelu4(const f32x4 v) { return (f32x4){gelu_f(v[0]), gelu_f(v[1]), gelu_f(v[2]), gelu_f(v[3])}; }
__device__ __forceinline__ f32x4 sigm4(const f32x4 v) { return (f32x4){sigm_f(v[0]), sigm_f(v[1]), sigm_f(v[2]), sigm_f(v[3])}; }
__device__ __forceinline__ f32x4 rcp4(const f32x4 v) { return (f32x4){__builtin_amdgcn_rcpf(v[0]), __builtin_amdgcn_rcpf(v[1]), __builtin_amdgcn_rcpf(v[2]), __builtin_amdgcn_rcpf(v[3])}; }

#define XB_TMO      128
#define XB_XCNT(j)  (256  + 64 * (j))
#define XB_XSUB(j)  (1280 + 64 * (j))
#define XB_XGEN(j)  (2304 + 64 * (j))
#define XB_TOP      3328
#define XB_TOPGEN   3392
#define XCD_BAR_WORDS 3456
#define XB_SPIN_CAP (1u << 18)
__device__ __forceinline__ unsigned xb_ld(unsigned* p)              { return __hip_atomic_load(p, __ATOMIC_RELAXED, __HIP_MEMORY_SCOPE_AGENT); }
__device__ __forceinline__ unsigned xb_add(unsigned* p, unsigned v) { return __hip_atomic_fetch_add(p, v, __ATOMIC_RELAXED, __HIP_MEMORY_SCOPE_AGENT); }
__device__ __forceinline__ unsigned xb_xcc_id() { return (unsigned)__builtin_amdgcn_s_getreg((3 << 11) | 20) & 0xFu; }
#define XB_SPIN(cond, bar) do { unsigned _sp = 0; while (cond) { __builtin_amdgcn_s_sleep(1); \
    if ((++_sp & 255u) == 0u) { if (xb_ld(&(bar)[XB_TMO])) break; if (_sp > XB_SPIN_CAP) { atomicAdd(&(bar)[XB_TMO], 1u); break; } } } } while (0)
struct XcdBarrier { unsigned* bar; unsigned x; volatile LAS unsigned* st; };
__device__ __forceinline__ XcdBarrier xcd_barrier_post(unsigned* bar, volatile LAS unsigned* st) {
    XcdBarrier b; b.bar = bar; b.x = xb_xcc_id(); b.st = st;
    if (threadIdx.x == 0) (void)xb_add(&bar[XB_XCNT(b.x)], 1u);
    return b;
}
__device__ __forceinline__ void xcd_barrier_complete(unsigned* bar, unsigned x, unsigned& nloc, unsigned& nx) {
    const unsigned G = gridDim.x * gridDim.y * gridDim.z;
    unsigned sum, cnt, mine, sp = 0u;
    for (;;) {
        sum = 0u; cnt = 0u; mine = 0u;
#pragma unroll
        for (unsigned j = 0; j < 16; ++j) { const unsigned c = xb_ld(&bar[XB_XCNT(j)]); sum += c; cnt += (c > 0u) ? 1u : 0u; mine = (j == x) ? c : mine; }
        if (sum == G) break;
        __builtin_amdgcn_s_sleep(1);
        if ((++sp & 255u) == 0u) { if (xb_ld(&bar[XB_TMO])) break; if (sp > XB_SPIN_CAP) { atomicAdd(&bar[XB_TMO], 1u); break; } }
    }
    nloc = mine > 0u ? mine : 1u; nx = cnt > 0u ? cnt : 1u;
}
__device__ __forceinline__ void xcd_barrier(const XcdBarrier& b) {
    asm volatile("s_waitcnt vmcnt(0)" ::: "memory");
    __syncthreads();
    if (threadIdx.x == 0) {
        unsigned* bar = b.bar;
        __builtin_amdgcn_s_waitcnt(0);
        unsigned nloc = b.st[0], nx = b.st[1];
        if (nloc == 0u) { xcd_barrier_complete(bar, b.x, nloc, nx); b.st[0] = nloc; b.st[1] = nx; }
        const unsigned old = xb_add(&bar[XB_XSUB(b.x)], 1u);
        const unsigned gen = old / nloc;
        if (old + 1u == (gen + 1u) * nloc) {
            __builtin_amdgcn_fence(__ATOMIC_RELEASE, "agent");
            asm volatile("s_waitcnt vmcnt(0)" ::: "memory");
            const unsigned og = xb_add(&bar[XB_TOP], 1u);
            const unsigned tg = og / nx;
            if (og + 1u == (tg + 1u) * nx) xb_add(&bar[XB_TOPGEN], 1u);
            else XB_SPIN(xb_ld(&bar[XB_TOPGEN]) == tg, bar);
            __builtin_amdgcn_fence(__ATOMIC_ACQUIRE, "agent");
            xb_add(&bar[XB_XGEN(b.x)], 1u);
            asm volatile("s_waitcnt vmcnt(0)" ::: "memory");
        } else {
            XB_SPIN(xb_ld(&bar[XB_XGEN(b.x)]) == gen, bar);
            __builtin_amdgcn_fence(__ATOMIC_ACQUIRE, "agent");
            asm volatile("s_waitcnt vmcnt(0)" ::: "memory");
        }
    }
    __syncthreads();
}

__host__ __device__ __forceinline__ int lds_byte(int r, int c) { const int st = (r >> 4) * 2 + (c >> 5), rr = r & 15, cc = c & 31, ob = rr * 64 + cc * 2; return st * 1024 + (ob ^ (((ob >> 9) & 1) << 5)); }
__host__ __device__ __forceinline__ void stage_rc(int b, int& R, int& C) { const int st = b / 1024, sb = b % 1024, swz = sb ^ (((sb >> 9) & 1) << 5); R = (st >> 1) * 16 + swz / 64; C = (st & 1) * 32 + (swz % 64) / 2; }
__host__ __device__ __forceinline__ int perm32(int rho) { const int n = rho >> 4, i = rho & 15; return 8 * (i >> 2) + 4 * n + (i & 3); }
struct Unit { const char* a; const char* b; int pm, pn, sub; };

struct TileOrder {
    int nM, nN, nwg, G, c; const char* A; const char* B; size_t ta, tb;
    __device__ __forceinline__ void init(int M, int N, int G_, int c_, const void* A_, int lda, const void* B_, int ldb) { nM = M / BM; nN = N / BM; nwg = nM * nN; G = G_; c = c_; A = (const char*)A_; B = (const char*)B_; ta = (size_t)BM * lda * 2; tb = (size_t)BM * ldb * 2; }
    __device__ __forceinline__ bool tile(long L, int& pm, int& pn) const {
        if (L >= nwg) return false;
        int wgid = (int)L; { const int q = nwg / NXCD, r = nwg % NXCD, xcd = wgid % NXCD, off = wgid / NXCD; wgid = (xcd < r ? xcd * (q + 1) : r * (q + 1) + (xcd - r) * q) + off; }
        const int nig = WGM * nN, gid = wgid / nig, fm = gid * WGM, gsz = (nM - fm) < WGM ? (nM - fm) : WGM;
        pm = fm + ((wgid % nig) % gsz); pn = (wgid % nig) / gsz; return true;
    }
    __device__ __forceinline__ bool next(int i, Unit& u) const { if (!tile((long)i * G + c, u.pm, u.pn)) return false; u.a = A + (size_t)u.pm * ta; u.b = B + (size_t)u.pn * tb; u.sub = 0; return true; }
};

template <class Epi, class Sched>
__device__ __forceinline__ void gemm_phase(LAS unsigned char* lds, const int lda, const int ldb, const int nt, const Sched S, const Epi E) {
    const int tid = threadIdx.x, wid = __builtin_amdgcn_readfirstlane(tid >> 6), lane = tid & 63, wr = wid >> 2, wc = wid & 3, fr = lane & 15, fq = lane >> 4;
    unsigned voffA[2], voffB[2];
#pragma unroll
    for (int i = 0; i < 2; ++i) { int R, C; stage_rc(tid * 16 + i * 8192, R, C); const int Rb = Epi::PERM ? ((R & ~31) + perm32(R & 31)) : R;
        voffA[i] = (unsigned)(R * lda + C) * 2u; voffB[i] = (unsigned)(Rb * ldb + C) * 2u; }
    const size_t kstep = (size_t)(BK * 2);
    const size_t hstepA = (size_t)HALF * lda * 2, hstepB = (size_t)HALF * ldb * 2;
    const unsigned ldsw = (unsigned)wid * 1024u;
    const int aoff = lds_byte(wr * 64 + fr, fq * 8), boff = lds_byte(wc * 32 + fr, fq * 8);
#define PG8_SA(b, h) (((b) * 2 + (h)) * HTB)
#define PG8_SB(b, h) ((4 + (b) * 2 + (h)) * HTB)
#define PG8_STAGE(bufoff, gbase, voff) do { _Pragma("unroll") for (int _i = 0; _i < 2; ++_i) \
        __builtin_amdgcn_global_load_lds((const unsigned*)((const char*)(gbase) + (voff)[_i]), (LAS unsigned*)(lds + (bufoff) + ldsw + _i * 8192), 16, 0, 0); } while (0)
#define PG8_LDA(dst, b, h) do { _Pragma("unroll") for (int m = 0; m < 4; ++m) _Pragma("unroll") for (int k = 0; k < 2; ++k) dst[m][k] = *(const LAS bf16x8*)(lds + PG8_SA(b, h) + aoff + m * 2048 + k * 1024); } while (0)
#define PG8_LDB(dst, b, h) do { _Pragma("unroll") for (int n = 0; n < 2; ++n) _Pragma("unroll") for (int k = 0; k < 2; ++k) dst[n][k] = *(const LAS bf16x8*)(lds + PG8_SB(b, h) + boff + n * 2048 + k * 1024); } while (0)
#define PG8_MMA(ai, bj, At, Bt) do { __builtin_amdgcn_s_setprio(1); _Pragma("unroll") for (int m = 0; m < 4; ++m) _Pragma("unroll") for (int n = 0; n < 2; ++n) _Pragma("unroll") for (int k = 0; k < 2; ++k) \
        acc[ai][bj][m][n] = __builtin_amdgcn_mfma_f32_16x16x32_bf16(Bt[n][k], At[m][k], acc[ai][bj][m][n], 0, 0, 0); __builtin_amdgcn_s_setprio(0); } while (0)
#define PG8_WAIT_V(n) asm volatile("s_waitcnt vmcnt(" #n ")" ::: "memory")
#define PG8_WAIT_L(n) asm volatile("s_waitcnt lgkmcnt(" #n ")" ::: "memory")
#define PG8_BAR __builtin_amdgcn_s_barrier()
#define PG8_SCHED __builtin_amdgcn_sched_barrier(0)
    Unit cur, nxt; int ui = 0;
    if (!S.next(0, cur)) return;
    f32x4 acc[2][2][4][2];
#pragma unroll
    for (int a = 0; a < 2; ++a)
#pragma unroll
        for (int b = 0; b < 2; ++b)
#pragma unroll
            for (int m = 0; m < 4; ++m)
#pragma unroll
                for (int n = 0; n < 2; ++n) acc[a][b][m][n] = (f32x4){0.f, 0.f, 0.f, 0.f};
    bf16x8 At[4][2], B0[2][2], B1[2][2];
    const char* cA = cur.a; const char* cB = cur.b;
    PG8_STAGE(PG8_SB(0, 0), cB, voffB); PG8_STAGE(PG8_SB(0, 1), cB + hstepB, voffB); PG8_STAGE(PG8_SA(0, 0), cA, voffA); PG8_STAGE(PG8_SA(0, 1), cA + hstepA, voffA);
    if (wr == 1) PG8_BAR;
    PG8_WAIT_V(2); PG8_BAR;
    PG8_STAGE(PG8_SB(1, 0), cB + kstep, voffB); PG8_STAGE(PG8_SA(1, 0), cA + kstep, voffA); PG8_STAGE(PG8_SB(1, 1), cB + hstepB + kstep, voffB);
    PG8_WAIT_V(6); PG8_BAR;
    for (;;) {
        const bool has_next = S.next(ui + 1, nxt);
        const char* nA = has_next ? nxt.a : cA; const char* nB = has_next ? nxt.b : cB;
#pragma unroll 1
        for (int t = 0; t < nt; t += 2) {
            const bool last = (t == nt - 2);
            const char* a1 = cA + (size_t)(t + 1) * kstep;
            const char* a2 = last ? nA : cA + (size_t)(t + 2) * kstep; const char* b2 = last ? nB : cB + (size_t)(t + 2) * kstep;
            const char* a3 = a2 + kstep; const char* b3 = b2 + kstep;
            PG8_LDB(B0, 0, 0); PG8_LDB(B1, 0, 1); PG8_SCHED; PG8_LDA(At, 0, 0); PG8_STAGE(PG8_SA(1, 1), a1 + hstepA, voffA);
            PG8_WAIT_V(8); PG8_WAIT_L(0); PG8_BAR; PG8_MMA(0, 0, At, B0); PG8_MMA(0, 1, At, B1); PG8_BAR; PG8_SCHED;
            PG8_LDA(At, 0, 1); PG8_STAGE(PG8_SB(0, 0), b2, voffB); PG8_STAGE(PG8_SB(0, 1), b2 + hstepB, voffB); PG8_STAGE(PG8_SA(0, 0), a2, voffA);
            PG8_WAIT_V(8); PG8_WAIT_L(0); PG8_BAR; PG8_MMA(1, 0, At, B0); PG8_MMA(1, 1, At, B1); PG8_BAR; PG8_SCHED;
            PG8_LDB(B0, 1, 0); PG8_LDB(B1, 1, 1); PG8_SCHED; PG8_LDA(At, 1, 0); PG8_STAGE(PG8_SA(0, 1), a2 + hstepA, voffA);
            PG8_WAIT_V(8); PG8_WAIT_L(0); PG8_BAR; PG8_MMA(0, 0, At, B0); PG8_MMA(0, 1, At, B1); PG8_BAR; PG8_SCHED;
            PG8_LDA(At, 1, 1); PG8_STAGE(PG8_SB(1, 0), b3, voffB); PG8_STAGE(PG8_SB(1, 1), b3 + hstepB, voffB); PG8_STAGE(PG8_SA(1, 0), a3, voffA);
            PG8_WAIT_V(8); PG8_WAIT_L(0); PG8_BAR; PG8_MMA(1, 0, At, B0); PG8_MMA(1, 1, At, B1); PG8_BAR; PG8_SCHED;
        }
        if (wr == 0) PG8_BAR;
        const bool reset = E(acc, cur, wr, wc, fr, fq);
        if (!has_next) break;
        if (reset) {
#pragma unroll
            for (int a = 0; a < 2; ++a)
#pragma unroll
                for (int b = 0; b < 2; ++b)
#pragma unroll
                    for (int m = 0; m < 4; ++m)
#pragma unroll
                        for (int n = 0; n < 2; ++n) acc[a][b][m][n] = (f32x4){0.f, 0.f, 0.f, 0.f};
        }
        cur = nxt; cA = nA; cB = nB; ++ui;
        if (wr == 1) PG8_BAR;
    }
    PG8_WAIT_V(0);
    PG8_BAR;
#undef PG8_SA
#undef PG8_SB
#undef PG8_STAGE
#undef PG8_LDA
#undef PG8_LDB
#undef PG8_MMA
#undef PG8_WAIT_V
#undef PG8_WAIT_L
#undef PG8_BAR
#undef PG8_SCHED
}

typedef f32x4 (&AccRef)[2][2][4][2];
#define EPI_LOOP_AM _Pragma("unroll") for (int ai = 0; ai < 2; ++ai) _Pragma("unroll") for (int m = 0; m < 4; ++m)
struct EpiInprojM {
    static constexpr bool PERM = true;
    bf16_t *Ag, *gu, *gv, *q, *gates; const float* b_gate;
    __device__ __forceinline__ bool operator()(AccRef acc, const Unit& u, int wr, int wc, int fr, int fq) const {
        const int row0 = u.pm * BM + wr * 64 + fr, cl = wc * 32 + 8 * fq, pn = u.pn;
        if (pn < 2) {
            EPI_LOOP_AM { const int row = row0 + ai * HALF + m * 16;
#pragma unroll
                for (int bj = 0; bj < 2; ++bj) { const int c = pn * 256 + bj * HALF + cl, g = c >> 4, hp = c & 15;
                    *(u32x4*)(Ag + ((size_t)(g * NCH + (row >> 4)) * KE + (row & 15) * 16 + hp)) = pack8(acc[ai][bj][m][0], acc[ai][bj][m][1]); } }
        } else if (pn < 6) {
            bf16_t* base = (pn < 4 ? gu : gv) + (pn & 1) * 256 + cl;
            EPI_LOOP_AM { const int row = row0 + ai * HALF + m * 16;
#pragma unroll
                for (int bj = 0; bj < 2; ++bj) *(u32x4*)(base + (size_t)row * 512 + bj * HALF) = pack8(gelu4(acc[ai][bj][m][0]), gelu4(acc[ai][bj][m][1])); }
        } else if (pn < 8) {
            bf16_t* base = q + (pn & 1) * 256 + cl;
            EPI_LOOP_AM { const int row = row0 + ai * HALF + m * 16;
#pragma unroll
                for (int bj = 0; bj < 2; ++bj) *(u32x4*)(base + (size_t)row * 512 + bj * HALF) = pack8(acc[ai][bj][m][0] * 0.08838834764831845f, acc[ai][bj][m][1] * 0.08838834764831845f); }
        } else {
            const int cg = (pn - 8) * 256 + cl;
            f32x4 bv[2][2];
#pragma unroll
            for (int bj = 0; bj < 2; ++bj) { bv[bj][0] = *(const f32x4*)(b_gate + cg + bj * HALF); bv[bj][1] = *(const f32x4*)(b_gate + cg + bj * HALF + 4); }
            EPI_LOOP_AM { const int row = row0 + ai * HALF + m * 16;
#pragma unroll
                for (int bj = 0; bj < 2; ++bj) *(u32x4*)(gates + (size_t)row * 3072 + cg + bj * HALF) = pack8(sigm4(acc[ai][bj][m][0] + bv[bj][0]), sigm4(acc[ai][bj][m][1] + bv[bj][1])); }
        }
        return true;
    }
};
struct EpiKVM {
    static constexpr bool PERM = true;
    bf16_t *kb, *vT;
    __device__ __forceinline__ bool operator()(AccRef acc, const Unit& u, int wr, int wc, int fr, int fq) const {
        const int row0 = u.pm * BM + wr * 64 + fr, cl = wc * 32 + 8 * fq, pn = u.pn;
        if (pn < 2) {
            EPI_LOOP_AM { const int row = row0 + ai * HALF + m * 16;
#pragma unroll
                for (int bj = 0; bj < 2; ++bj) *(u32x4*)(kb + (size_t)row * 512 + pn * 256 + bj * HALF + cl) = pack8(acc[ai][bj][m][0], acc[ai][bj][m][1]); }
        } else {
            EPI_LOOP_AM { const int row = row0 + ai * HALF + m * 16, b = row >> 8, mm = row & 255;
#pragma unroll
                for (int bj = 0; bj < 2; ++bj) { const int hd = (pn - 2) * 256 + bj * HALF + cl; bf16_t* dst = vT + ((size_t)b * 512 + hd) * 256 + mm;
#pragma unroll
                    for (int n = 0; n < 2; ++n)
#pragma unroll
                        for (int j = 0; j < 4; ++j) dst[(size_t)(n * 4 + j) * 256] = (bf16_t)(cvtpk(acc[ai][bj][m][n][j], 0.f) & 0xffffu); } }
        }
        return true;
    }
};
struct EpiS5YM {
    static constexpr bool PERM = true;
    bf16_t* yap;
    __device__ __forceinline__ bool operator()(AccRef acc, const Unit& u, int wr, int wc, int fr, int fq) const {
        const int g = u.pm >> 2, mch0 = (u.pm & 3) * BM + wr * 64 + fr, cl = wc * 32 + 8 * fq;
        EPI_LOOP_AM { const int mch = mch0 + ai * HALF + m * 16;
#pragma unroll
            for (int bj = 0; bj < 2; ++bj) { const int n = bj * HALF + cl, tau = n >> 4, hh = n & 15; const size_t tg = (size_t)mch * 16 + tau;
                *(u32x4*)(yap + tg * 512 + g * 16 + hh) = pack8(gelu4(acc[ai][bj][m][0]), gelu4(acc[ai][bj][m][1])); } }
        return true;
    }
};
struct EpiGluM {
    static constexpr bool PERM = true;
    const bf16_t* yap; const float* b_glu; bf16_t* yag;
    __device__ __forceinline__ bool operator()(AccRef acc, const Unit& u, int wr, int wc, int fr, int fq) const {
        const int row0 = u.pm * BM + wr * 64 + fr, c0 = u.pn * 256 + wc * 32 + 8 * fq;
        f32x4 bv[2][2];
#pragma unroll
        for (int bj = 0; bj < 2; ++bj) { bv[bj][0] = *(const f32x4*)(b_glu + c0 + bj * HALF); bv[bj][1] = *(const f32x4*)(b_glu + c0 + bj * HALF + 4); }
        EPI_LOOP_AM { const size_t ro = (size_t)(row0 + ai * HALF + m * 16) * 512 + c0;
#pragma unroll
            for (int bj = 0; bj < 2; ++bj) { const u32x4 yv = *(const u32x4*)(yap + ro + bj * HALF);
                *(u32x4*)(yag + ro + bj * HALF) = pack8(unpk_lo(yv) * sigm4(acc[ai][bj][m][0] + bv[bj][0]), unpk_hi(yv) * sigm4(acc[ai][bj][m][1] + bv[bj][1])); } }
        return true;
    }
};
struct EpiMergeM {
    static constexpr bool PERM = true;
    const bf16_t* gates; bf16_t* merged;
    __device__ __forceinline__ bool operator()(AccRef acc, const Unit& u, int wr, int wc, int fr, int fq) const {
        const int row0 = u.pm * BM + wr * 64 + fr, c0 = u.pn * 256 + wc * 32 + 8 * fq, sub = u.sub;
        EPI_LOOP_AM { const int row = row0 + ai * HALF + m * 16; const bf16_t* gr = gates + (size_t)row * 3072 + c0;
#pragma unroll
            for (int bj = 0; bj < 2; ++bj) {
                if (sub < 2) { const u32x4 nu = *(const u32x4*)(gr + sub * 1024 + bj * HALF), de = *(const u32x4*)(gr + (sub + 1) * 1024 + bj * HALF);
                    acc[ai][bj][m][0] = acc[ai][bj][m][0] * (unpk_lo(nu) * rcp4(unpk_lo(de))); acc[ai][bj][m][1] = acc[ai][bj][m][1] * (unpk_hi(nu) * rcp4(unpk_hi(de))); }
                else { const u32x4 g2 = *(const u32x4*)(gr + 2048 + bj * HALF);
                    *(u32x4*)(merged + (size_t)row * D + c0 + bj * HALF) = pack8(acc[ai][bj][m][0] * unpk_lo(g2), acc[ai][bj][m][1] * unpk_hi(g2)); } } }
        return sub == 2;
    }
};
struct EpiResM {
    static constexpr bool PERM = false;
    const float* base; float* out; bf16_t* ob; float* ss;
    __device__ __forceinline__ bool operator()(AccRef acc, const Unit& u, int wr, int wc, int fr, int fq) const {
        const int row0 = u.pm * BM + wr * 64 + fr, c0 = u.pn * 256 + wc * 32 + 4 * fq;
        EPI_LOOP_AM { const int row = row0 + ai * HALF + m * 16; const size_t ro = (size_t)row * D + c0; float s = 0.f;
#pragma unroll
            for (int bj = 0; bj < 2; ++bj)
#pragma unroll
                for (int n = 0; n < 2; ++n) { const f32x4 v = *(const f32x4*)(base + ro + bj * HALF + n * 16) + acc[ai][bj][m][n];
                    *(f32x4*)(out + ro + bj * HALF + n * 16) = v; s += (v[0] * v[0] + v[1] * v[1]) + (v[2] * v[2] + v[3] * v[3]);
                    if (ob) { u32x2 w; w.x = cvtpk(v[0], v[1]); w.y = cvtpk(v[2], v[3]); *(u32x2*)(ob + ro + bj * HALF + n * 16) = w; } }
            s += __shfl_xor(s, 16); s += __shfl_xor(s, 32);
            if (fq == 0) __hip_atomic_fetch_add(ss + row, s, __ATOMIC_RELAXED, __HIP_MEMORY_SCOPE_AGENT); }
        return true;
    }
};
struct EpiFfnUpM {
    static constexpr bool PERM = true;
    const float* ss1; bf16_t* act;
    __device__ __forceinline__ bool operator()(AccRef acc, const Unit& u, int wr, int wc, int fr, int fq) const {
        const int row0 = u.pm * BM + wr * 64 + fr, c0 = u.pn * 128 + wc * 32 + 8 * fq;
        EPI_LOOP_AM { const int row = row0 + ai * HALF + m * 16; const float rs = rsqrtf(ss1[row] * (1.f / D) + EPS);
            f32x4 o[2];
#pragma unroll
            for (int n = 0; n < 2; ++n) { const f32x4 gg = acc[ai][0][m][n] * rs, uu = acc[ai][1][m][n] * rs; o[n] = gg * sigm4(gg) * uu; }
            *(u32x4*)(act + (size_t)row * DFF + c0) = pack8(o[0], o[1]); }
        return true;
    }
};

struct MergeOrder { TileOrder T; const char *a0, *b0; long da1, da2, db1, db2; size_t ta, tb;
    __device__ __forceinline__ bool next(int i, Unit& u) const { const int j = i / 3, s = i - 3 * j; if (!T.tile((long)j * T.G + T.c, u.pm, u.pn)) return false;
        const long s1 = (s == 1) ? 1 : 0, s2 = (s == 2) ? 1 : 0;
        u.a = a0 + s1 * da1 + s2 * da2 + (size_t)u.pm * ta; u.b = b0 + s1 * db1 + s2 * db2 + (size_t)u.pn * tb; u.sub = s; return true; } };
struct S5YOrder { int G, c; const char* Ag; const char* Km;
    __device__ __forceinline__ bool next(int i, Unit& u) const { const int L = i * G + c; if (L >= 128) return false; const int g = L >> 2, rt = L & 3;
        u.a = Ag + ((size_t)g * NCH + 256 * rt) * KE * 2; u.b = Km + (size_t)g * 256 * KE * 2; u.pm = L; u.pn = 0; u.sub = 0; return true; } };
struct KvOrder { int G, c; const char* A; const char* B;
    __device__ __forceinline__ bool next(int i, Unit& u) const { const int first = G >= 32 ? G - 32 : 0, str = G >= 32 ? 32 : G; if (c < first) return false; const int L = i * str + (c - first); if (L >= 32) return false;
        u.pm = L >> 2; u.pn = L & 3; u.a = A + (size_t)u.pm * BM * D * 2; u.b = B + (size_t)u.pn * BM * D * 2; u.sub = 0; return true; } };

__device__ __forceinline__ void p0_transpose_item(const float* __restrict__ W, int K, int N, bf16_t* __restrict__ WT, int ldt, const float* __restrict__ scale, int mode, LAS float* scr, int item, int lane) {
    const int nblk = N / 32, kb = item / nblk, nb = item % nblk, k0 = 64 * kb, n0 = 32 * nb;
#pragma unroll 8
    for (int i = 0; i < 32; ++i) { const int kk = 2 * i + (lane >> 5); float v = W[(size_t)(k0 + kk) * N + n0 + (lane & 31)]; if (scale) v *= scale[k0 + kk]; scr[kk * 33 + (lane & 31)] = v; }
    LDS_WAIT(); asm volatile("" ::: "memory");
    const int c = lane & 7;
#pragma unroll
    for (int j = 0; j < 4; ++j) { const int n = (lane >> 3) + 8 * j; const LAS float* s = scr + (8 * c) * 33 + n;
        u32x4 o; o.x = cvtpk(s[0 * 33], s[1 * 33]); o.y = cvtpk(s[2 * 33], s[3 * 33]); o.z = cvtpk(s[4 * 33], s[5 * 33]); o.w = cvtpk(s[6 * 33], s[7 * 33]);
        const int ng = n0 + n, drow = mode == 0 ? ng : 256 * (ng >> 7) + 128 * (mode - 1) + (ng & 127);
        *(u32x4*)(WT + (size_t)drow * ldt + k0 + 8 * c) = o; }
    LDS_WAIT(); asm volatile("" ::: "memory");
}
__device__ __forceinline__ void rms_row_bf16(const float* __restrict__ xrow, const float* __restrict__ g, bf16_t* __restrict__ orow, int lane) {
    const f32x4* xr = (const f32x4*)xrow + lane; f32x4 v[4]; float s = 0.f;
#pragma unroll
    for (int j = 0; j < 4; ++j) { v[j] = xr[64 * j]; s += (v[j][0] * v[j][0] + v[j][1] * v[j][1]) + (v[j][2] * v[j][2] + v[j][3] * v[j][3]); }
    const float rs = rsqrtf(wave_sum(s) * (1.f / D) + EPS);
#pragma unroll
    for (int j = 0; j < 4; ++j) { const f32x4 gg = ((const f32x4*)g)[64 * j + lane]; const f32x4 o = v[j] * rs * gg; u32x2 w; w.x = cvtpk(o[0], o[1]); w.y = cvtpk(o[2], o[3]); ((u32x2*)orow)[64 * j + lane] = w; }
}

struct MArgs { const float* in[30]; float* out; unsigned char* ws; int mask, bars; };

__device__ __forceinline__ void prep_phase(const MArgs& a, LAS unsigned char* lds, int G, int bx, int tid, int wave, int lane) {
    unsigned char* ws = a.ws;
    for (int blk = bx; blk < 256; blk += G) {
        const int g = blk >> 3, j = blk & 7;
        LAS float* E = (LAS float*)lds; LAS float* Bb = (LAS float*)(lds + 8704); LAS float* Kt = (LAS float*)(lds + 16896);
        if (tid < 64) {
            const int idx = g * 64 + tid;
            const double dt = (double)expf(a.in[7][g]), ar = a.in[5][idx], ai = a.in[6][idx];
            const double xm = ar * dt;
            double mag = 1.0; { double term = 1.0; for (int i = 1; i <= 12; ++i) { term *= xm / (double)i; mag += term; } }
            const double th = ai * dt, kq = __builtin_rint(th * 0.6366197723675814);
            const double r = __builtin_fma(-kq, 6.123233995736766e-17, __builtin_fma(-kq, 1.5707963267948966, th)), r2 = r * r;
            const double sr = r * (1.0 + r2 * (-1.0 / 6 + r2 * (1.0 / 120 + r2 * (-1.0 / 5040 + r2 * (1.0 / 362880 + r2 * (-1.0 / 39916800 + r2 * (1.0 / 6227020800.0)))))));
            const double cr = 1.0 + r2 * (-0.5 + r2 * (1.0 / 24 + r2 * (-1.0 / 720 + r2 * (1.0 / 40320 + r2 * (-1.0 / 3628800 + r2 * (1.0 / 479001600 + r2 * (-1.0 / 87178291200.0)))))));
            const int qd = ((int)kq) & 3;
            const double cs = (qd == 0) ? cr : (qd == 1) ? -sr : (qd == 2) ? -cr : sr, sn = (qd == 0) ? sr : (qd == 1) ? cr : (qd == 2) ? -sr : -cr;
            const double abr = mag * cs, abi = mag * sn;
            const double nr = abr - 1.0, den = ar * ar + ai * ai, fre = (nr * ar + abi * ai) / den, fim = (abi * ar - nr * ai) / den;
            double er = 1.0, ei = 0.0;
#pragma unroll 1
            for (int t = 0; t <= LC; ++t) { E[(tid * 17 + t) * 2] = (float)er; E[(tid * 17 + t) * 2 + 1] = (float)ei; const double n1 = er * abr - ei * abi, n2 = er * abi + ei * abr; er = n1; ei = n2; }
#pragma unroll 1
            for (int h = 0; h < 16; ++h) { const double br = a.in[8][idx * 16 + h], bi = a.in[9][idx * 16 + h]; Bb[(tid * 16 + h) * 2] = (float)(fre * br - fim * bi); Bb[(tid * 16 + h) * 2 + 1] = (float)(fre * bi + fim * br); }
        }
        __syncthreads();
        const float* cmr = a.in[10] + (size_t)g * 16 * 64; const float* cmi = a.in[11] + (size_t)g * 16 * 64;
#pragma unroll 1
        for (int i = 0; i < 8; ++i) {
            const int e = tid + 512 * i, tau = e >> 8, h = (e >> 4) & 15, hp = e & 15; float s = 0.f;
#pragma unroll 4
            for (int p = 0; p < 64; ++p) { const float er = E[(p * 17 + tau) * 2], ei = E[(p * 17 + tau) * 2 + 1], br = Bb[(p * 16 + hp) * 2], bi = Bb[(p * 16 + hp) * 2 + 1];
                s += cmr[h * 64 + p] * (er * br - ei * bi) - cmi[h * 64 + p] * (er * bi + ei * br); }
            if (tau == 0 && hp == h) s += a.in[12][g * 16 + h];
            Kt[e] = s;
        }
        __syncthreads();
        bf16_t* Km = (bf16_t*)(ws + WS_KMAT) + (size_t)g * 256 * KE; bf16_t* We = (bf16_t*)(ws + WS_WEND) + (size_t)g * 128 * 256;
#pragma unroll 1
        for (int i = 0; i < 24; ++i) {
            const int idx = tid + 512 * i, nl = idx / KE, k = idx - nl * KE, n = 32 * j + nl, to = n >> 4, h = n & 15; float val = 0.f;
            if (k < 256) { const int ti = k >> 4, hp = k & 15; if (ti <= to) val = Kt[(to - ti) * 256 + h * 16 + hp]; }
            else { const int pp = k - 256, p = pp & 63, im = pp >> 6; const float cr = cmr[h * 64 + p], ci = cmi[h * 64 + p], er = E[(p * 17 + to + 1) * 2], ei = E[(p * 17 + to + 1) * 2 + 1];
                val = im ? -(cr * ei + ci * er) : (cr * er - ci * ei); }
            Km[(size_t)n * KE + k] = f2bf(val);
        }
#pragma unroll 1
        for (int i = 0; i < 8; ++i) {
            const int idx = tid + 512 * i, ppl = idx >> 8, k = idx & 255, pp = 16 * j + ppl, p = pp & 63, im = pp >> 6, tau = k >> 4, hp = k & 15;
            const float er = E[(p * 17 + (LC - 1 - tau)) * 2], ei = E[(p * 17 + (LC - 1 - tau)) * 2 + 1], br = Bb[(p * 16 + hp) * 2], bi = Bb[(p * 16 + hp) * 2 + 1];
            We[(size_t)pp * 256 + k] = f2bf(im ? (er * bi + ei * br) : (er * br - ei * bi));
        }
        if (j == 0 && tid < 64) { float* a16 = (float*)(ws + WS_TABE) + (size_t)(g * 64 + tid) * 2; a16[0] = E[(tid * 17 + LC) * 2]; a16[1] = E[(tid * 17 + LC) * 2 + 1]; }
        __syncthreads();
    }
    LAS float* scr = (LAS float*)(lds + wave * 16384);
    const int gw = bx * NWAVES + wave, NGW = G * NWAVES;
    constexpr int I_IN = (D / 64) * (INW / 32), I_G = (D / 64) * (DFF / 32), I_D = (DFF / 64) * (D / 32), I_KV = (D / 64) * (1024 / 32), I_O = I_KV, I_ABC = (512 / 64) * (D / 32), I_GLU = (512 / 64) * (512 / 32);
    constexpr int NITEMS = I_IN + 2 * I_G + I_D + I_KV + I_O + 3 * I_ABC + I_GLU;
#pragma unroll 1
    for (int it = gw; it < NITEMS; it += NGW) {
        int r = it;
        if (r < I_IN) { p0_transpose_item(a.in[3], D, INW, (bf16_t*)(ws + WS_WIN), D, nullptr, 0, scr, r, lane); continue; } r -= I_IN;
        if (r < I_G) { p0_transpose_item(a.in[26], D, DFF, (bf16_t*)(ws + WS_WGU), D, a.in[25], 1, scr, r, lane); continue; } r -= I_G;
        if (r < I_G) { p0_transpose_item(a.in[27], D, DFF, (bf16_t*)(ws + WS_WGU), D, a.in[25], 2, scr, r, lane); continue; } r -= I_G;
        if (r < I_D) { p0_transpose_item(a.in[28], DFF, D, (bf16_t*)(ws + WS_WD), DFF, nullptr, 0, scr, r, lane); continue; } r -= I_D;
        if (r < I_KV) { p0_transpose_item(a.in[20], D, 1024, (bf16_t*)(ws + WS_WKV), D, nullptr, 0, scr, r, lane); continue; } r -= I_KV;
        if (r < I_O) { p0_transpose_item(a.in[24], D, D, (bf16_t*)(ws + WS_WOUT), D, nullptr, 0, scr, r, lane); continue; } r -= I_O;
        if (r < I_ABC) { p0_transpose_item(a.in[21], 512, D, (bf16_t*)(ws + WS_WA), 512, nullptr, 0, scr, r, lane); continue; } r -= I_ABC;
        if (r < I_ABC) { p0_transpose_item(a.in[22], 512, D, (bf16_t*)(ws + WS_WB), 512, nullptr, 0, scr, r, lane); continue; } r -= I_ABC;
        if (r < I_ABC) { p0_transpose_item(a.in[23], 512, D, (bf16_t*)(ws + WS_WC), 512, nullptr, 0, scr, r, lane); continue; } r -= I_ABC;
        p0_transpose_item(a.in[13], 512, 512, (bf16_t*)(ws + WS_WGLU), 512, nullptr, 0, scr, r, lane);
    }
#pragma unroll 1
    for (int r = gw; r < T + TM; r += NGW) {
        if (r < T) rms_row_bf16(a.in[0] + (size_t)r * D, a.in[2], (bf16_t*)(ws + WS_R1) + (size_t)r * D, lane);
        else rms_row_bf16(a.in[1] + (size_t)(r - T) * D, a.in[19], (bf16_t*)(ws + WS_MEMN) + (size_t)(r - T) * D, lane);
    }
    { bf16_t* Wm = (bf16_t*)(ws + WS_WM); const float* w_s = a.in[17];
      for (int e = bx * NTHREADS + tid; e < SGG * SGB * SGB; e += G * NTHREADS) { const int t = (e >> 7) & 127, s = e & 127; Wm[e] = (s <= t) ? f2bf(w_s[e]) : (bf16_t)0; } }
}
__device__ __forceinline__ void s5l_phase(const MArgs& a, LAS unsigned char* lds, int G, int bx, int tid, int wave, int lane) {
    unsigned char* ws = a.ws;
    bf16_t* Ag = (bf16_t*)(ws + WS_R2); const bf16_t* WendT = (const bf16_t*)(ws + WS_WEND); const float* A16 = (const float*)(ws + WS_TABE);
    const int fr = lane & 15, fq = lane >> 4;
    LAS float* L = (LAS float*)lds;
#pragma unroll 1
    for (int task = bx; task < 256; task += G) {
        const int g = task >> 3, b = task & 7;
        const bf16_t* Arow = Ag + ((size_t)g * NCH + b * 128 + wave * 16 + fr) * KE + fq * 8;
        bf16x8 af[8];
#pragma unroll
        for (int ks = 0; ks < 8; ++ks) af[ks] = *(const bf16x8*)(Arow + 32 * ks);
        const bf16_t* Brow = WendT + ((size_t)g * 128 + fr) * 256 + fq * 8;
#pragma unroll
        for (int nt = 0; nt < 8; ++nt) {
            f32x4 acc = (f32x4){0.f, 0.f, 0.f, 0.f};
#pragma unroll
            for (int ks = 0; ks < 8; ++ks) { const bf16x8 bfr = *(const bf16x8*)(Brow + nt * 4096 + ks * 32); acc = __builtin_amdgcn_mfma_f32_16x16x32_bf16(af[ks], bfr, acc, 0, 0, 0); }
#pragma unroll
            for (int r = 0; r < 4; ++r) L[(wave * 16 + 4 * fq + r) * 128 + nt * 16 + fr] = acc[r];
        }
        __syncthreads();
        if (tid < 64) {
            const float ar = A16[(g * 64 + tid) * 2], ai = A16[(g * 64 + tid) * 2 + 1];
            float sr = 0.f, si = 0.f;
            bf16_t* dst = Ag + ((size_t)g * NCH + b * 128) * KE + 256 + tid;
#pragma unroll 8
            for (int m = 0; m < 128; ++m) {
                dst[(size_t)m * KE] = f2bf(sr); dst[(size_t)m * KE + 64] = f2bf(si);
                const float lr = L[m * 128 + tid], li = L[m * 128 + 64 + tid];
                const float nr = ar * sr - ai * si + lr, ni = ar * si + ai * sr + li; sr = nr; si = ni;
            }
        }
        __syncthreads();
    }
}

__device__ __forceinline__ void sgu_phase(const MArgs& a, LAS unsigned char* lds, int G, int bx, int tid, int wave, int lane) {
    unsigned char* ws = a.ws;
    const bf16_t* gu = (const bf16_t*)((unsigned char*)a.out + 16 * MiB); const bf16_t* gv = (const bf16_t*)((unsigned char*)a.out + 32 * MiB); bf16_t* sgu = (bf16_t*)((unsigned char*)a.out + 48 * MiB);
    const bf16_t* Wm = (const bf16_t*)(ws + WS_WM); const float* b_s = a.in[18]; const float* gam = a.in[15]; const float* bet = a.in[16];
    const int fr = lane & 15, fq = lane >> 4;
    LAS float* st = (LAS float*)lds;
    LAS unsigned char* vTl = lds + 1024;
#pragma unroll 1
    for (int unit = bx; unit < T / SGB; unit += G) {
        const int t0 = unit * SGB;
#pragma unroll 1
        for (int i = 0; i < 16; ++i) {
            const int s = wave * 16 + i;
            const u32x4 rv = *(const u32x4*)(gv + (size_t)(t0 + s) * 512 + lane * 8);
            const f32x4 v0 = unpk_lo(rv), v1 = unpk_hi(rv);
            const float mu = wave_sum((v0[0] + v0[1]) + (v0[2] + v0[3]) + (v1[0] + v1[1]) + (v1[2] + v1[3])) * (1.f / 512.f);
            const f32x4 d0 = v0 - mu, d1 = v1 - mu;
            const float var = wave_sum((d0[0] * d0[0] + d0[1] * d0[1]) + (d0[2] * d0[2] + d0[3] * d0[3]) + (d1[0] * d1[0] + d1[1] * d1[1]) + (d1[2] * d1[2] + d1[3] * d1[3])) * (1.f / 512.f);
            if (lane == 0) { st[s * 2] = mu; st[s * 2 + 1] = rsqrtf(var + EPS); }
        }
        __syncthreads();
#pragma unroll 1
        for (int g = 0; g < SGG; ++g) {
#pragma unroll
            for (int i = 0; i < 4; ++i) {
                const int id = i * 512 + tid, s = id & 127, dc = id >> 7, ch = g * 128 + dc * 8;
                const u32x4 rv = *(const u32x4*)(gv + (size_t)(t0 + s) * 512 + ch);
                const float mu = st[s * 2], rs = st[s * 2 + 1];
                const f32x4 g0 = *(const f32x4*)(gam + ch), g1 = *(const f32x4*)(gam + ch + 4), b0 = *(const f32x4*)(bet + ch), b1 = *(const f32x4*)(bet + ch + 4);
                const f32x4 o0 = (unpk_lo(rv) - mu) * rs * g0 + b0, o1 = (unpk_hi(rv) - mu) * rs * g1 + b1;
                LAS bf16_t* dp = (LAS bf16_t*)(vTl + (dc * 8) * 272 + s * 2);
                dp[0 * 136] = f2bf(o0[0]); dp[1 * 136] = f2bf(o0[1]); dp[2 * 136] = f2bf(o0[2]); dp[3 * 136] = f2bf(o0[3]);
                dp[4 * 136] = f2bf(o1[0]); dp[5 * 136] = f2bf(o1[1]); dp[6 * 136] = f2bf(o1[2]); dp[7 * 136] = f2bf(o1[3]);
            }
            __syncthreads();
            f32x4 acc[8];
#pragma unroll
            for (int nt = 0; nt < 8; ++nt) acc[nt] = (f32x4){0.f, 0.f, 0.f, 0.f};
            const int ksmax = (wave * 16 + 15) >> 5;
            const bf16_t* Wrow = Wm + ((size_t)(g * 128 + wave * 16 + fr)) * 128 + fq * 8;
#pragma unroll 1
            for (int ks = 0; ks <= ksmax; ++ks) {
                const bf16x8 wf = *(const bf16x8*)(Wrow + ks * 32);
#pragma unroll
                for (int nt = 0; nt < 8; ++nt) { const bf16x8 vf = *(const LAS bf16x8*)(vTl + (nt * 16 + fr) * 272 + (ks * 32 + fq * 8) * 2); acc[nt] = __builtin_amdgcn_mfma_f32_16x16x32_bf16(vf, wf, acc[nt], 0, 0, 0); }
            }
            const int t = wave * 16 + fr; const float bias = b_s[g * 128 + t];
            const size_t ro = (size_t)(t0 + t) * 512 + g * 128 + 4 * fq;
#pragma unroll
            for (int nt = 0; nt < 8; ++nt) {
                const u32x2 uv = *(const u32x2*)(gu + ro + nt * 16);
                const float u0 = __uint_as_float(uv.x << 16), u1 = __uint_as_float(uv.x & 0xffff0000u), u2 = __uint_as_float(uv.y << 16), u3 = __uint_as_float(uv.y & 0xffff0000u);
                u32x2 w; w.x = cvtpk(u0 * (acc[nt][0] + bias), u1 * (acc[nt][1] + bias)); w.y = cvtpk(u2 * (acc[nt][2] + bias), u3 * (acc[nt][3] + bias));
                *(u32x2*)(sgu + ro + nt * 16) = w;
            }
            __syncthreads();
        }
    }
}

constexpr int AT_KROW = 272, AT_VROW = 528, AT_VOFF = 256 * AT_KROW;
__device__ __forceinline__ void attn_phase(const MArgs& a, LAS unsigned char* lds, int G, int bx, int tid, int wave, int lane) {
    unsigned char* ws = a.ws;
    const bf16_t* q = (const bf16_t*)((unsigned char*)a.out); const bf16_t* kb = (const bf16_t*)(ws + WS_KB); const bf16_t* vT = (const bf16_t*)(ws + WS_VT); bf16_t* ob = (bf16_t*)(ws + WS_R6);
    const int fr = lane & 15, fq = lane >> 4;
    LAS unsigned char* Ks = lds; LAS unsigned char* Vs = lds + AT_VOFF;
#pragma unroll 1
    for (int unit = bx; unit < NB * XH * 8; unit += G) {
        const int b = unit >> 5, hh = (unit >> 3) & 3, qb = unit & 7, t0 = b * SEQ + qb * 256;
#pragma unroll
        for (int i = 0; i < 8; ++i) { const int id = i * 512 + tid, row = id >> 4, ch = id & 15;
            *(LAS u32x4*)(Ks + row * AT_KROW + ch * 16) = *(const u32x4*)(kb + (size_t)(b * 256 + row) * 512 + hh * 128 + ch * 8); }
#pragma unroll
        for (int i = 0; i < 8; ++i) { const int id = i * 512 + tid, row = id >> 5, ch = id & 31;
            *(LAS u32x4*)(Vs + row * AT_VROW + ch * 16) = *(const u32x4*)(vT + ((size_t)(b * 4 + hh) * 128 + row) * 256 + ch * 8); }
        __syncthreads();
#pragma unroll 1
        for (int mt = 0; mt < 2; ++mt) {
            const int trow = t0 + wave * 32 + mt * 16 + fr;
            bf16x8 qf[4];
#pragma unroll
            for (int ks = 0; ks < 4; ++ks) qf[ks] = *(const bf16x8*)(q + (size_t)trow * 512 + hh * 128 + ks * 32 + fq * 8);
            f32x4 s[16];
#pragma unroll
            for (int nt = 0; nt < 16; ++nt) { s[nt] = (f32x4){0.f, 0.f, 0.f, 0.f};
#pragma unroll
                for (int ks = 0; ks < 4; ++ks) { const bf16x8 kf = *(const LAS bf16x8*)(Ks + (nt * 16 + fr) * AT_KROW + (ks * 32 + fq * 8) * 2); s[nt] = __builtin_amdgcn_mfma_f32_16x16x32_bf16(kf, qf[ks], s[nt], 0, 0, 0); }
                if (nt & 1) __builtin_amdgcn_sched_barrier(0); }
            float mx = s[0][0];
#pragma unroll
            for (int nt = 0; nt < 16; ++nt) mx = fmaxf(fmaxf(mx, fmaxf(s[nt][0], s[nt][1])), fmaxf(s[nt][2], s[nt][3]));
            mx = fmaxf(mx, __shfl_xor(mx, 16)); mx = fmaxf(mx, __shfl_xor(mx, 32));
            const float mneg = -mx * 1.4426950408889634f; float l = 0.f;
#pragma unroll
            for (int nt = 0; nt < 16; ++nt)
#pragma unroll
                for (int r = 0; r < 4; ++r) { const float p = __builtin_amdgcn_exp2f(__builtin_fmaf(s[nt][r], 1.4426950408889634f, mneg)); s[nt][r] = p; l += p; }
            l += __shfl_xor(l, 16); l += __shfl_xor(l, 32);
            bf16x8 pf[8];
#pragma unroll
            for (int k2 = 0; k2 < 8; ++k2) { const u32x4 w = pack8(s[2 * k2], s[2 * k2 + 1]); pf[k2] = __builtin_bit_cast(bf16x8, w); }
            const float rl = 1.f / l;
            bf16_t* orow = ob + (size_t)trow * 512 + hh * 128 + 4 * fq;
#pragma unroll
            for (int dt = 0; dt < 8; ++dt) {
                f32x4 o = (f32x4){0.f, 0.f, 0.f, 0.f};
#pragma unroll
                for (int k2 = 0; k2 < 8; ++k2) {
                    const LAS unsigned char* vp = Vs + (dt * 16 + fr) * AT_VROW + (k2 * 32 + fq * 4) * 2;
                    const u32x2 lo = *(const LAS u32x2*)vp, hi = *(const LAS u32x2*)(vp + 32);
                    const u32x4 vv = (u32x4){lo.x, lo.y, hi.x, hi.y};
                    o = __builtin_amdgcn_mfma_f32_16x16x32_bf16(__builtin_bit_cast(bf16x8, vv), pf[k2], o, 0, 0, 0);
                }
                u32x2 w; w.x = cvtpk(o[0] * rl, o[1] * rl); w.y = cvtpk(o[2] * rl, o[3] * rl);
                *(u32x2*)(orow + dt * 16) = w;
                __builtin_amdgcn_sched_barrier(0);
            }
        }
        __syncthreads();
    }
}

#ifndef PH_EN
#define PH_EN W_ALL
#endif
__global__ void __launch_bounds__(NTHREADS, 2) mega_fwd(MArgs a) {
    extern __shared__ __attribute__((aligned(16))) unsigned char lds_raw[];
    LAS unsigned char* lds = (LAS unsigned char*)lds_raw;
    const int tid = threadIdx.x, lane = tid & 63, wave = __builtin_amdgcn_readfirstlane(tid >> 6);
    const int G = gridDim.x, bx = blockIdx.x, mask = a.mask;
    unsigned char* ws = a.ws;
    for (int u = tid; u < (LDS_BYTES - LDSCTL_OFF) / 4; u += NTHREADS) ((LAS unsigned*)(lds + LDSCTL_OFF))[u] = 0u;
    __syncthreads();
    XcdBarrier bar; bar.bar = (unsigned*)(ws + WS_CTL) + CW_BAR; bar.x = 0; bar.st = nullptr;
    if (a.bars) bar = xcd_barrier_post((unsigned*)(ws + WS_CTL) + CW_BAR, (volatile LAS unsigned*)(lds + LDSCTL_OFF) + 8);
#define GRID_BAR(k) do { if (a.bars & (1 << (k))) xcd_barrier(bar); } while (0)
#define P_BF(off) ((bf16_t*)(ws + (off)))
#define WinT P_BF(WS_WIN)
#define WguT P_BF(WS_WGU)
#define WdT P_BF(WS_WD)
#define WkvT P_BF(WS_WKV)
#define WoutT P_BF(WS_WOUT)
#define WaT P_BF(WS_WA)
#define WbT P_BF(WS_WB)
#define WcT P_BF(WS_WC)
#define WgluT P_BF(WS_WGLU)
#define KmatT P_BF(WS_KMAT)
#define memn P_BF(WS_MEMN)
#define kb P_BF(WS_KB)
#define vT P_BF(WS_VT)
#define h P_BF(WS_R1)
#define yap P_BF(WS_R1)
#define merged P_BF(WS_R1)
#define Ag P_BF(WS_R2)
#define yag P_BF(WS_R2)
#define x1b P_BF(WS_R2)
#define ob P_BF(WS_R6)
#define gates P_BF(WS_R7)
#define act P_BF(WS_R7)
#define q ((bf16_t*)((unsigned char*)a.out))
#define gu ((bf16_t*)((unsigned char*)a.out + 16 * MiB))
#define gv ((bf16_t*)((unsigned char*)a.out + 32 * MiB))
#define sgu ((bf16_t*)((unsigned char*)a.out + 48 * MiB))
#define ss1 ((float*)(ws + WS_CTL + CTL_SS1))
#define ss2 ((float*)(ws + WS_CTL + CTL_SS2))
    if ((PH_EN & W_PREP) && (mask & W_PREP)) prep_phase(a, lds, G, bx, tid, wave, lane);
    GRID_BAR(0);
    if ((PH_EN & W_INPROJ) && (mask & W_INPROJ)) { TileOrder S; S.init(T, INW, G, bx, h, D, WinT, D); EpiInprojM E{Ag, gu, gv, q, gates, a.in[4]}; gemm_phase(lds, D, D, D / BK, S, E); }
    GRID_BAR(1);
    if ((PH_EN & W_S5L) && (mask & W_S5L)) s5l_phase(a, lds, G, bx, tid, wave, lane);
    if ((PH_EN & W_KV) && (mask & W_KV)) { KvOrder S{G, bx, (const char*)memn, (const char*)WkvT}; EpiKVM E{kb, vT}; gemm_phase(lds, D, D, D / BK, S, E); }
    if ((PH_EN & W_SGU) && (mask & W_SGU)) sgu_phase(a, lds, G, bx, tid, wave, lane);
    GRID_BAR(2);
    if ((PH_EN & W_S5Y) && (mask & W_S5Y)) { S5YOrder S{G, bx, (const char*)Ag, (const char*)KmatT}; EpiS5YM E{yap}; gemm_phase(lds, KE, KE, KE / BK, S, E); }
    if ((PH_EN & W_ATTN) && (mask & W_ATTN)) attn_phase(a, lds, G, bx, tid, wave, lane);
    GRID_BAR(3);
    if ((PH_EN & W_GLU) && (mask & W_GLU)) { TileOrder S; S.init(T, 512, G, bx, yap, 512, WgluT, 512); EpiGluM E{yap, a.in[14], yag}; gemm_phase(lds, 512, 512, 512 / BK, S, E); }
    GRID_BAR(4);
    if ((PH_EN & W_MERGE) && (mask & W_MERGE)) { MergeOrder S; S.T.init(T, D, G, bx, nullptr, 512, nullptr, 512); S.a0 = (const char*)yag; S.da1 = (const char*)sgu - (const char*)yag; S.da2 = (const char*)ob - (const char*)yag;
        S.b0 = (const char*)WaT; S.db1 = (const char*)WbT - (const char*)WaT; S.db2 = (const char*)WcT - (const char*)WaT; S.ta = (size_t)BM * 512 * 2; S.tb = (size_t)BM * 512 * 2;
        EpiMergeM E{gates, merged}; gemm_phase(lds, 512, 512, 512 / BK, S, E); }
    GRID_BAR(5);
    if ((PH_EN & W_WOUT) && (mask & W_WOUT)) { TileOrder S; S.init(T, D, G, bx, merged, D, WoutT, D); EpiResM E{a.in[0], a.out, x1b, ss1}; gemm_phase(lds, D, D, D / BK, S, E); }
    GRID_BAR(6);
    if ((PH_EN & W_FFNUP) && (mask & W_FFNUP)) { TileOrder S; S.init(T, NGU, G, bx, x1b, D, WguT, D); EpiFfnUpM E{ss1, act}; gemm_phase(lds, D, D, D / BK, S, E); }
    GRID_BAR(7);
    if ((PH_EN & W_FFNDOWN) && (mask & W_FFNDOWN)) { TileOrder S; S.init(T, D, G, bx, act, DFF, WdT, DFF); EpiResM E{a.out, a.out, nullptr, ss2}; gemm_phase(lds, DFF, DFF, DFF / BK, S, E); }
    GRID_BAR(8);
    if ((PH_EN & W_FINAL) && (mask & W_FINAL)) {
        const int gw = bx * NWAVES + wave, NGW = G * NWAVES; const float* gf = a.in[29];
        for (int r = gw; r < T; r += NGW) { f32x4* xr = (f32x4*)(a.out + (size_t)r * D) + lane; const float rs = rsqrtf(ss2[r] * (1.f / D) + EPS);
#pragma unroll
            for (int j = 0; j < 4; ++j) { const f32x4 gg = ((const f32x4*)gf)[64 * j + lane]; xr[64 * j] = xr[64 * j] * rs * gg; } }
    }
#undef GRID_BAR
#undef WinT
#undef WguT
#undef WdT
#undef WkvT
#undef WoutT
#undef WaT
#undef WbT
#undef WcT
#undef WgluT
#undef KmatT
#undef memn
#undef kb
#undef vT
#undef h
#undef yap
#undef merged
#undef Ag
#undef yag
#undef x1b
#undef ob
#undef gates
#undef act
#undef q
#undef gu
#undef gv
#undef sgu
#undef ss1
#undef ss2
}

#ifndef MEGA_STAGES
#define MEGA_STAGES 0
#endif
#ifndef ONE_LAUNCH
#define ONE_LAUNCH 0
#endif
extern "C" void kernel_launch(void* const* d_in, const int* in_sizes, int n_in, void* d_out, int out_size, void* d_ws, size_t ws_size, hipStream_t stream) {
    static int grid = 0;
    if (grid == 0) {
        if (n_in != 30 || out_size != T * D || ws_size < WS_END) { fprintf(stderr, "kernel_launch: unexpected sizes n_in %d out %d ws %zu\n", n_in, out_size, ws_size); grid = -1; return; }
        int dev = 0, cus = 0, per_cu = 0;
        if (hipGetDevice(&dev) != hipSuccess || hipDeviceGetAttribute(&cus, hipDeviceAttributeMultiprocessorCount, dev) != hipSuccess) { grid = -1; return; }
        if (hipFuncSetAttribute((const void*)mega_fwd, hipFuncAttributeMaxDynamicSharedMemorySize, LDS_BYTES) != hipSuccess) { fprintf(stderr, "kernel_launch: hipFuncSetAttribute failed\n"); grid = -1; return; }
        if (hipOccupancyMaxActiveBlocksPerMultiprocessor(&per_cu, (const void*)mega_fwd, NTHREADS, LDS_BYTES) != hipSuccess || per_cu < 1) { fprintf(stderr, "kernel_launch: occupancy query says %d blocks/CU\n", per_cu); (void)hipGetLastError(); }
        grid = cus;
    }
    if (grid < 0) return;
    const float* x = (const float*)d_in[0]; const float* mem = (const float*)d_in[1]; const float* g_mix = (const float*)d_in[2]; const float* w_in = (const float*)d_in[3];
    const float* b_gate = (const float*)d_in[4]; const float* a_re = (const float*)d_in[5]; const float* a_im = (const float*)d_in[6]; const float* log_dt = (const float*)d_in[7];
    const float* bm_re = (const float*)d_in[8]; const float* bm_im = (const float*)d_in[9]; const float* cm_re = (const float*)d_in[10]; const float* cm_im = (const float*)d_in[11];
    const float* d_skip = (const float*)d_in[12]; const float* w_glu = (const float*)d_in[13]; const float* b_glu = (const float*)d_in[14]; const float* g_sgu = (const float*)d_in[15];
    const float* beta_sgu = (const float*)d_in[16]; const float* w_s = (const float*)d_in[17]; const float* b_s = (const float*)d_in[18]; const float* g_mem = (const float*)d_in[19];
    const float* w_kv = (const float*)d_in[20]; const float* w_a = (const float*)d_in[21]; const float* w_b = (const float*)d_in[22]; const float* w_c = (const float*)d_in[23];
    const float* w_out = (const float*)d_in[24]; const float* g_ffn = (const float*)d_in[25]; const float* w_gate = (const float*)d_in[26]; const float* w_up = (const float*)d_in[27];
    const float* w_down = (const float*)d_in[28]; const float* g_final = (const float*)d_in[29];
    unsigned char* ws = (unsigned char*)d_ws; float* out = (float*)d_out;
    bf16_t* WinT = (bf16_t*)(ws + WS_WIN); bf16_t* WguT = (bf16_t*)(ws + WS_WGU); bf16_t* WdT = (bf16_t*)(ws + WS_WD); bf16_t* WkvT = (bf16_t*)(ws + WS_WKV); bf16_t* WoutT = (bf16_t*)(ws + WS_WOUT);
    bf16_t* WaT = (bf16_t*)(ws + WS_WA); bf16_t* WbT = (bf16_t*)(ws + WS_WB); bf16_t* WcT = (bf16_t*)(ws + WS_WC); bf16_t* WgluT = (bf16_t*)(ws + WS_WGLU);
    bf16_t* KmatT = (bf16_t*)(ws + WS_KMAT); bf16_t* WendT = (bf16_t*)(ws + WS_WEND); bf16_t* Wm = (bf16_t*)(ws + WS_WM); float* tabE = (float*)(ws + WS_TABE); float* tabB = (float*)(ws + WS_TABB);
    float* sgst = (float*)(ws + WS_SGST); bf16_t* memn = (bf16_t*)(ws + WS_MEMN); bf16_t* kb = (bf16_t*)(ws + WS_KB); bf16_t* vT = (bf16_t*)(ws + WS_VT);
    bf16_t* h = (bf16_t*)(ws + WS_R1); bf16_t* yap = (bf16_t*)(ws + WS_R1); bf16_t* merged = (bf16_t*)(ws + WS_R1);
    bf16_t* Ag = (bf16_t*)(ws + WS_R2); bf16_t* yag = (bf16_t*)(ws + WS_R2); bf16_t* x1b = (bf16_t*)(ws + WS_R2); bf16_t* ob = (bf16_t*)(ws + WS_R6);
    bf16_t* gates = (bf16_t*)(ws + WS_R7); bf16_t* act = (bf16_t*)(ws + WS_R7);
    bf16_t* q = (bf16_t*)((unsigned char*)d_out); bf16_t* gu = (bf16_t*)((unsigned char*)d_out + 16 * MiB); bf16_t* gv = (bf16_t*)((unsigned char*)d_out + 32 * MiB); bf16_t* sgu = (bf16_t*)((unsigned char*)d_out + 48 * MiB);
    float* ss1 = (float*)(ws + WS_CTL + CTL_SS1); float* ss2 = (float*)(ws + WS_CTL + CTL_SS2);
    (void)tabE; (void)tabB; (void)KmatT; (void)WendT;

    MArgs ma{};
    for (int i = 0; i < 30; ++i) ma.in[i] = (const float*)d_in[i];
    ma.out = out; ma.ws = ws;
    (void)hipMemsetAsync(ws + WS_CTL, 0, 1 * MiB, stream);
#define MEGA(m, b) do { ma.mask = (m); ma.bars = (b); hipLaunchKernelGGL(mega_fwd, dim3(grid), dim3(NTHREADS), LDS_BYTES, stream, ma); } while (0)
#define ISM(w) ((MEGA_STAGES) & (w))
    if (ONE_LAUNCH) { MEGA(W_ALL, 0x1ff); return; }
    if (ISM(W_PREP)) MEGA(W_PREP, 0);
    else {
        k_tconv<<<dim3(INW / 64, D / 64), 512, 0, stream>>>(w_in, D, INW, WinT, D, nullptr, 0, 0);
        k_tconv<<<dim3(DFF / 64, D / 64), 512, 0, stream>>>(w_gate, D, DFF, WguT, D, g_ffn, 1, 0);
        k_tconv<<<dim3(DFF / 64, D / 64), 512, 0, stream>>>(w_up, D, DFF, WguT, D, g_ffn, 2, 0);
        k_tconv<<<dim3(D / 64, DFF / 64), 512, 0, stream>>>(w_down, DFF, D, WdT, DFF, nullptr, 0, 0);
        k_tconv<<<dim3(1024 / 64, D / 64), 512, 0, stream>>>(w_kv, D, 1024, WkvT, D, nullptr, 0, 0);
        k_tconv<<<dim3(D / 64, D / 64), 512, 0, stream>>>(w_out, D, D, WoutT, D, nullptr, 0, 0);
        k_tconv<<<dim3(D / 64, 512 / 64), 512, 0, stream>>>(w_a, 512, D, WaT, 512, nullptr, 0, 0);
        k_tconv<<<dim3(D / 64, 512 / 64), 512, 0, stream>>>(w_b, 512, D, WbT, 512, nullptr, 0, 0);
        k_tconv<<<dim3(D / 64, 512 / 64), 512, 0, stream>>>(w_c, 512, D, WcT, 512, nullptr, 0, 0);
        k_tconv<<<dim3(512 / 64, 512 / 64), 512, 0, stream>>>(w_glu, 512, 512, WgluT, 512, nullptr, 0, 0);
        k_rmsrows<<<T / 8, 512, 0, stream>>>(x, g_mix, h, T);
        k_rmsrows<<<TM / 8, 512, 0, stream>>>(mem, g_mem, memn, TM);
        k_s5tab<<<(S5G * S5P + 255) / 256, 256, 0, stream>>>(a_re, a_im, log_dt, bm_re, bm_im, tabE, tabB);
        k_s5mats<<<dim3((256 * KE + 128 * 256) / 256, S5G), 256, 0, stream>>>(tabE, tabB, cm_re, cm_im, d_skip, KmatT, WendT);
        k_wm<<<(SGG * SGB * SGB + 255) / 256, 256, 0, stream>>>(w_s, Wm);
    }
    if (ISM(W_INPROJ)) MEGA(W_INPROJ, 0); else k_ngemm<EpiInproj><<<dim3(INW / 64, T / 4), 256, 0, stream>>>(h, D, WinT, D, D, EpiInproj{Ag, gu, gv, q, gates, b_gate});
    if (ISM(W_KV)) MEGA(W_KV, 0); else k_ngemm<EpiKV><<<dim3(1024 / 64, TM / 4), 256, 0, stream>>>(memn, D, WkvT, D, D, EpiKV{kb, vT});
    if (ISM(W_S5L)) { MEGA(W_S5L, 0); MEGA(W_S5Y, 0); } else k_s5_naive<<<NB * S5G, 64, 0, stream>>>(Ag, a_re, a_im, log_dt, bm_re, bm_im, cm_re, cm_im, d_skip, yap);
    if (ISM(W_ATTN)) MEGA(W_ATTN, 0); else k_attn_naive<<<T * XH, 256, 0, stream>>>(q, kb, vT, ob);
    if (ISM(W_SGU)) MEGA(W_SGU, 0);
    else { k_sgu_stats<<<T / 8, 512, 0, stream>>>(gv, sgst); k_sgu_naive<<<dim3(2, T), 256, 0, stream>>>(gu, gv, sgst, Wm, b_s, g_sgu, beta_sgu, sgu); }
    if (ISM(W_GLU)) MEGA(W_GLU, 0); else k_ngemm<EpiGlu><<<dim3(512 / 64, T / 4), 256, 0, stream>>>(yap, 512, WgluT, 512, 512, EpiGlu{yap, b_glu, yag});
    if (ISM(W_MERGE)) MEGA(W_MERGE, 0); else k_merge_naive<<<dim3(D / 64, T / 4), 256, 0, stream>>>(yag, sgu, ob, WaT, WbT, WcT, gates, merged);
    if (ISM(W_WOUT)) MEGA(W_WOUT, 0);
    else { k_ngemm<EpiWout><<<dim3(D / 64, T / 4), 256, 0, stream>>>(merged, D, WoutT, D, D, EpiWout{x, out, x1b}); k_rowss<<<T / 8, 512, 0, stream>>>(out, ss1); }
    if (ISM(W_FFNUP)) MEGA(W_FFNUP, 0); else k_ffnup_naive<<<dim3(DFF / 64, T / 4), 256, 0, stream>>>(x1b, WguT, ss1, act);
    if (ISM(W_FFNDOWN)) MEGA(W_FFNDOWN, 0);
    else { k_ngemm<EpiDown><<<dim3(D / 64, T / 4), 256, 0, stream>>>(act, DFF, WdT, DFF, DFF, EpiDown{out}); k_rowss<<<T / 8, 512, 0, stream>>>(out, ss2); }
    if (ISM(W_FINAL)) MEGA(W_FINAL, 0); else k_final<<<T * D / 4 / 256, 256, 0, stream>>>(out, ss2, g_final);
}
```

```cpp
#define MEGA_STAGES (W_ALL)
#define ONE_LAUNCH 1
#include <hip/hip_runtime.h>
#include <cstdio>
#include <cstdint>

typedef unsigned short bf16_t;
constexpr int NB = 8, SEQ = 2048, D = 1024, T = NB * SEQ, MEML = 256, TM = NB * MEML;
constexpr int S5W = 512, S5G = 32, S5H = 16, S5P = 64, LC = 16, NCH = T / LC, KE = LC * S5H + 2 * S5P;
constexpr int SGW = 512, SGG = 4, SGD = 128, SGB = 128;
constexpr int XH = 4, XD = 128, XW = 512;
constexpr int DFF = 2816, INW = 5120, NGU = 2 * DFF;
constexpr float EPS = 1e-6f;
constexpr size_t MiB = 1u << 20;
constexpr size_t WS_CTL = 0;
constexpr size_t CTL_SS1 = 256 * 1024, CTL_SS2 = 384 * 1024;
constexpr size_t WS_WIN = 1 * MiB, WS_WGU = 11 * MiB, WS_WD = 22 * MiB, WS_WKV = 28 * MiB, WS_WOUT = 30 * MiB;
constexpr size_t WS_WA = 32 * MiB, WS_WB = 33 * MiB, WS_WC = 34 * MiB, WS_WGLU = 35 * MiB, WS_KMAT = 36 * MiB, WS_WEND = 42 * MiB;
constexpr size_t WS_WM = 44 * MiB, WS_TABE = 44 * MiB + 256 * 1024, WS_TABB = 44 * MiB + 512 * 1024, WS_SGST = 45 * MiB;
constexpr size_t WS_MEMN = 46 * MiB, WS_KB = 50 * MiB, WS_VT = 52 * MiB;
constexpr size_t WS_R1 = 56 * MiB;
constexpr size_t WS_R2 = 88 * MiB;
constexpr size_t WS_R6 = 112 * MiB;
constexpr size_t WS_R7 = 128 * MiB;
constexpr size_t WS_END = 224 * MiB;

__device__ __forceinline__ float bf2f(bf16_t v) { return __uint_as_float((unsigned)v << 16); }
__device__ __forceinline__ bf16_t f2bf(float f) { unsigned u = __float_as_uint(f); return (bf16_t)((u + 0x7fffu + ((u >> 16) & 1u)) >> 16); }
__device__ __forceinline__ float gelu_t(float x) { const float u = 0.7978845608028654f * (x + 0.044715f * x * x * x); return 0.5f * x * (1.f + tanhf(u)); }
__device__ __forceinline__ float sigm(float x) { return 1.f / (1.f + expf(-x)); }
__device__ __forceinline__ float wave_sum(float v) {
#pragma unroll
    for (int o = 1; o < 64; o <<= 1) v += __shfl_xor(v, o);
    return v;
}
__device__ __forceinline__ float wave_max(float v) {
#pragma unroll
    for (int o = 1; o < 64; o <<= 1) v = fmaxf(v, __shfl_xor(v, o));
    return v;
}
__device__ __forceinline__ float dot8(uint4 a, uint4 b) {
    float s = 0.f;
    s += __uint_as_float(a.x << 16) * __uint_as_float(b.x << 16) + __uint_as_float(a.x & 0xffff0000u) * __uint_as_float(b.x & 0xffff0000u);
    s += __uint_as_float(a.y << 16) * __uint_as_float(b.y << 16) + __uint_as_float(a.y & 0xffff0000u) * __uint_as_float(b.y & 0xffff0000u);
    s += __uint_as_float(a.z << 16) * __uint_as_float(b.z << 16) + __uint_as_float(a.z & 0xffff0000u) * __uint_as_float(b.z & 0xffff0000u);
    s += __uint_as_float(a.w << 16) * __uint_as_float(b.w << 16) + __uint_as_float(a.w & 0xffff0000u) * __uint_as_float(b.w & 0xffff0000u);
    return s;
}
__device__ __forceinline__ float dotrow(const bf16_t* a, const bf16_t* b, int K) {
    float acc = 0.f;
    for (int k = 0; k < K; k += 8) acc += dot8(*(const uint4*)(a + k), *(const uint4*)(b + k));
    return acc;
}

__global__ void __launch_bounds__(512) k_tconv(const float* __restrict__ W, int K, int N, bf16_t* __restrict__ WT, int ldt, const float* __restrict__ scale, int mode, int row_off) {
    __shared__ float tile[64][65];
    const int n0 = blockIdx.x * 64, k0 = blockIdx.y * 64, tid = threadIdx.x;
#pragma unroll
    for (int i = 0; i < 8; ++i) { const int kk = i * 8 + (tid >> 6), nn = tid & 63; float v = W[(size_t)(k0 + kk) * N + n0 + nn]; if (scale) v *= scale[k0 + kk]; tile[kk][nn] = v; }
    __syncthreads();
    const int n = tid >> 3, kc = tid & 7, ng = n0 + n;
    int drow;
    if (mode == 0) drow = ng + row_off; else drow = 256 * (ng >> 7) + 128 * (mode - 1) + (ng & 127);
    uint4 o;
    o.x = (unsigned)f2bf(tile[kc * 8 + 0][n]) | ((unsigned)f2bf(tile[kc * 8 + 1][n]) << 16);
    o.y = (unsigned)f2bf(tile[kc * 8 + 2][n]) | ((unsigned)f2bf(tile[kc * 8 + 3][n]) << 16);
    o.z = (unsigned)f2bf(tile[kc * 8 + 4][n]) | ((unsigned)f2bf(tile[kc * 8 + 5][n]) << 16);
    o.w = (unsigned)f2bf(tile[kc * 8 + 6][n]) | ((unsigned)f2bf(tile[kc * 8 + 7][n]) << 16);
    *(uint4*)(WT + (size_t)drow * ldt + k0 + kc * 8) = o;
}
__global__ void __launch_bounds__(512) k_rmsrows(const float* __restrict__ x, const float* __restrict__ g, bf16_t* __restrict__ out, int rows) {
    const int row = blockIdx.x * 8 + (threadIdx.x >> 6), lane = threadIdx.x & 63;
    if (row >= rows) return;
    const float4* xr = (const float4*)(x + (size_t)row * D) + lane;
    float4 v[4]; float s = 0.f;
#pragma unroll
    for (int j = 0; j < 4; ++j) { v[j] = xr[64 * j]; s += v[j].x * v[j].x + v[j].y * v[j].y + v[j].z * v[j].z + v[j].w * v[j].w; }
    const float rs = rsqrtf(wave_sum(s) * (1.f / D) + EPS);
#pragma unroll
    for (int j = 0; j < 4; ++j) {
        const float4 gg = ((const float4*)g)[64 * j + lane];
        uint2 o; o.x = (unsigned)f2bf(v[j].x * rs * gg.x) | ((unsigned)f2bf(v[j].y * rs * gg.y) << 16); o.y = (unsigned)f2bf(v[j].z * rs * gg.z) | ((unsigned)f2bf(v[j].w * rs * gg.w) << 16);
        ((uint2*)(out + (size_t)row * D))[64 * j + lane] = o;
    }
}
__global__ void k_s5tab(const float* a_re, const float* a_im, const float* log_dt, const float* bm_re, const float* bm_im, float* tabE, float* tabB) {
    const int idx = blockIdx.x * blockDim.x + threadIdx.x; if (idx >= S5G * S5P) return;
    const int g = idx / S5P;
    const double dt = exp((double)log_dt[g]), ar = a_re[idx], ai = a_im[idx];
    const double mag = exp(ar * dt), th = ai * dt;
    const double abr = mag * cos(th), abi = mag * sin(th);
    const double nr = abr - 1.0, den = ar * ar + ai * ai;
    const double fre = (nr * ar + abi * ai) / den, fim = (abi * ar - nr * ai) / den;
    double er = 1.0, ei = 0.0;
    for (int t = 0; t <= LC; ++t) { tabE[(idx * 17 + t) * 2] = (float)er; tabE[(idx * 17 + t) * 2 + 1] = (float)ei; const double nr2 = er * abr - ei * abi, ni2 = er * abi + ei * abr; er = nr2; ei = ni2; }
    for (int h = 0; h < S5H; ++h) { const double br = bm_re[idx * S5H + h], bi = bm_im[idx * S5H + h]; tabB[(idx * 16 + h) * 2] = (float)(fre * br - fim * bi); tabB[(idx * 16 + h) * 2 + 1] = (float)(fre * bi + fim * br); }
}
__global__ void __launch_bounds__(256) k_s5mats(const float* __restrict__ tabE, const float* __restrict__ tabB, const float* __restrict__ cm_re, const float* __restrict__ cm_im, const float* __restrict__ d_skip, bf16_t* __restrict__ KmatT, bf16_t* __restrict__ WendT) {
    const int g = blockIdx.y;
    const int e = blockIdx.x * 256 + threadIdx.x;
    const float* E = tabE + (size_t)g * S5P * 17 * 2; const float* Bb = tabB + (size_t)g * S5P * 16 * 2;
    if (e < 256 * KE) {
        const int n = e / KE, k = e % KE, to = n >> 4, h = n & 15; float val = 0.f;
        if (k < 256) {
            const int ti = k >> 4, hp = k & 15;
            if (ti <= to) {
                const int tau = to - ti; float s = 0.f;
                for (int p = 0; p < S5P; ++p) {
                    const float cr = cm_re[(g * 16 + h) * 64 + p], ci = cm_im[(g * 16 + h) * 64 + p];
                    const float er = E[(p * 17 + tau) * 2], ei = E[(p * 17 + tau) * 2 + 1];
                    const float br = Bb[(p * 16 + hp) * 2], bi = Bb[(p * 16 + hp) * 2 + 1];
                    const float xr = er * br - ei * bi, xi = er * bi + ei * br;
                    s += cr * xr - ci * xi;
                }
                if (tau == 0 && hp == h) s += d_skip[g * 16 + h];
                val = s;
            }
        } else {
            const int pp = k - 256, p = pp & 63, im = pp >> 6;
            const float cr = cm_re[(g * 16 + h) * 64 + p], ci = cm_im[(g * 16 + h) * 64 + p];
            const float er = E[(p * 17 + to + 1) * 2], ei = E[(p * 17 + to + 1) * 2 + 1];
            val = im ? -(cr * ei + ci * er) : (cr * er - ci * ei);
        }
        KmatT[(size_t)g * 256 * KE + e] = f2bf(val);
    } else {
        const int e2 = e - 256 * KE; if (e2 >= 128 * 256) return;
        const int pp = e2 >> 8, k = e2 & 255, p = pp & 63, im = pp >> 6, tau = k >> 4, hp = k & 15;
        const float er = E[(p * 17 + (LC - 1 - tau)) * 2], ei = E[(p * 17 + (LC - 1 - tau)) * 2 + 1];
        const float br = Bb[(p * 16 + hp) * 2], bi = Bb[(p * 16 + hp) * 2 + 1];
        WendT[(size_t)g * 128 * 256 + e2] = f2bf(im ? (er * bi + ei * br) : (er * br - ei * bi));
    }
}
__global__ void k_wm(const float* __restrict__ w_s, bf16_t* __restrict__ Wm) {
    const int e = blockIdx.x * blockDim.x + threadIdx.x; if (e >= SGG * SGB * SGB) return;
    const int t = (e >> 7) & 127, s = e & 127; Wm[e] = (s <= t) ? f2bf(w_s[e]) : (bf16_t)0;
}

template <class Epi> __global__ void __launch_bounds__(256) k_ngemm(const bf16_t* __restrict__ A, int lda, const bf16_t* __restrict__ Bt, int ldb, int K, Epi e) {
    const int n = blockIdx.x * 64 + (threadIdx.x & 63), m = blockIdx.y * 4 + (threadIdx.x >> 6);
    e(m, n, dotrow(A + (size_t)m * lda, Bt + (size_t)n * ldb, K));
}
struct EpiInproj {
    bf16_t *Ag, *gu, *gv, *q, *gates; const float* b_gate;
    __device__ void operator()(int m, int n, float acc) const {
        if (n < 512) { const int g = n >> 4; Ag[((size_t)g * NCH + (m >> 4)) * KE + (m & 15) * 16 + (n & 15)] = f2bf(acc); }
        else if (n < 1024) gu[(size_t)m * 512 + n - 512] = f2bf(gelu_t(acc));
        else if (n < 1536) gv[(size_t)m * 512 + n - 1024] = f2bf(gelu_t(acc));
        else if (n < 2048) q[(size_t)m * 512 + n - 1536] = f2bf(acc * 0.08838834764831845f);
        else gates[(size_t)m * 3072 + n - 2048] = f2bf(sigm(acc + b_gate[n - 2048]));
    }
};
struct EpiKV {
    bf16_t *kb, *vT;
    __device__ void operator()(int m, int n, float acc) const {
        if (n < 512) kb[(size_t)m * 512 + n] = f2bf(acc);
        else { const int b = m >> 8, mm = m & 255, hd = n - 512; vT[((size_t)b * 512 + hd) * 256 + mm] = f2bf(acc); }
    }
};
struct EpiGlu {
    const bf16_t* yap; const float* b_glu; bf16_t* yag;
    __device__ void operator()(int m, int n, float acc) const { const float y = bf2f(yap[(size_t)m * 512 + n]); yag[(size_t)m * 512 + n] = f2bf(y * sigm(acc + b_glu[n])); }
};
struct EpiWout {
    const float* x; float* x1; bf16_t* x1b;
    __device__ void operator()(int m, int n, float acc) const { const float v = x[(size_t)m * D + n] + acc; x1[(size_t)m * D + n] = v; x1b[(size_t)m * D + n] = f2bf(v); }
};
struct EpiDown {
    float* x1;
    __device__ void operator()(int m, int n, float acc) const { x1[(size_t)m * D + n] += acc; }
};
__global__ void __launch_bounds__(64) k_s5_naive(const bf16_t* __restrict__ Ag, const float* a_re, const float* a_im, const float* log_dt, const float* bm_re, const float* bm_im,
                                                 const float* cm_re, const float* cm_im, const float* d_skip, bf16_t* __restrict__ yap) {
    const int b = blockIdx.x >> 5, g = blockIdx.x & 31, p = threadIdx.x;
    const float dt = expf(log_dt[g]), ar = a_re[g * 64 + p], ai = a_im[g * 64 + p];
    const float mag = expf(ar * dt), abr = mag * cosf(ai * dt), abi = mag * sinf(ai * dt);
    const float nr = abr - 1.f, den = ar * ar + ai * ai, fre = (nr * ar + abi * ai) / den, fim = (abi * ar - nr * ai) / den;
    float bbr[16], bbi[16], cr[16], ci[16];
#pragma unroll
    for (int h = 0; h < 16; ++h) {
        const float br = bm_re[(g * 64 + p) * 16 + h], bi = bm_im[(g * 64 + p) * 16 + h];
        bbr[h] = fre * br - fim * bi; bbi[h] = fre * bi + fim * br;
        cr[h] = cm_re[(g * 16 + h) * 64 + p]; ci[h] = cm_im[(g * 16 + h) * 64 + p];
    }
    const float dsk = d_skip[g * 16 + (p & 15)];
    float sr = 0.f, si = 0.f;
    for (int t = 0; t < SEQ; ++t) {
        const int tg = b * SEQ + t;
        const bf16_t* up = Ag + ((size_t)g * NCH + (tg >> 4)) * KE + (tg & 15) * 16;
        const uint4 u0 = *(const uint4*)up, u1 = *(const uint4*)(up + 8);
        float u[16];
        u[0] = __uint_as_float(u0.x << 16); u[1] = __uint_as_float(u0.x & 0xffff0000u); u[2] = __uint_as_float(u0.y << 16); u[3] = __uint_as_float(u0.y & 0xffff0000u);
        u[4] = __uint_as_float(u0.z << 16); u[5] = __uint_as_float(u0.z & 0xffff0000u); u[6] = __uint_as_float(u0.w << 16); u[7] = __uint_as_float(u0.w & 0xffff0000u);
        u[8] = __uint_as_float(u1.x << 16); u[9] = __uint_as_float(u1.x & 0xffff0000u); u[10] = __uint_as_float(u1.y << 16); u[11] = __uint_as_float(u1.y & 0xffff0000u);
        u[12] = __uint_as_float(u1.z << 16); u[13] = __uint_as_float(u1.z & 0xffff0000u); u[14] = __uint_as_float(u1.w << 16); u[15] = __uint_as_float(u1.w & 0xffff0000u);
        float bur = 0.f, bui = 0.f;
#pragma unroll
        for (int h = 0; h < 16; ++h) { bur += bbr[h] * u[h]; bui += bbi[h] * u[h]; }
        const float nsr = abr * sr - abi * si + bur, nsi = abr * si + abi * sr + bui; sr = nsr; si = nsi;
        float mine = 0.f, um = 0.f;
#pragma unroll
        for (int h = 0; h < 16; ++h) { const float y = wave_sum(cr[h] * sr - ci[h] * si); if (p == h) { mine = y; um = u[h]; } }
        if (p < 16) yap[(size_t)tg * 512 + g * 16 + p] = f2bf(gelu_t(mine + dsk * um));
    }
}
__global__ void __launch_bounds__(256) k_attn_naive(const bf16_t* __restrict__ q, const bf16_t* __restrict__ kb, const bf16_t* __restrict__ vT, bf16_t* __restrict__ o) {
    __shared__ float sc[256]; __shared__ float red[8];
    const int t = blockIdx.x >> 2, h = blockIdx.x & 3, b = t / SEQ, tid = threadIdx.x, lane = tid & 63, w = tid >> 6;
    const float s = dotrow(q + (size_t)t * 512 + h * 128, kb + (size_t)(b * 256 + tid) * 512 + h * 128, 128);
    float mx = wave_max(s); if (lane == 0) red[w] = mx; __syncthreads();
    mx = fmaxf(fmaxf(red[0], red[1]), fmaxf(red[2], red[3]));
    const float e = expf(s - mx); float sm = wave_sum(e); if (lane == 0) red[4 + w] = sm; __syncthreads();
    sm = red[4] + red[5] + red[6] + red[7];
    sc[tid] = e / sm; __syncthreads();
    if (tid < 128) {
        const bf16_t* vr = vT + ((size_t)b * 512 + h * 128 + tid) * 256; float acc = 0.f;
        for (int m = 0; m < 256; ++m) acc += sc[m] * bf2f(vr[m]);
        o[(size_t)t * 512 + h * 128 + tid] = f2bf(acc);
    }
}
__global__ void __launch_bounds__(512) k_sgu_stats(const bf16_t* __restrict__ gv, float* __restrict__ st) {
    const int row = blockIdx.x * 8 + (threadIdx.x >> 6), lane = threadIdx.x & 63;
    const uint4 r = ((const uint4*)(gv + (size_t)row * 512))[lane];
    float v[8]; v[0] = __uint_as_float(r.x << 16); v[1] = __uint_as_float(r.x & 0xffff0000u); v[2] = __uint_as_float(r.y << 16); v[3] = __uint_as_float(r.y & 0xffff0000u);
    v[4] = __uint_as_float(r.z << 16); v[5] = __uint_as_float(r.z & 0xffff0000u); v[6] = __uint_as_float(r.w << 16); v[7] = __uint_as_float(r.w & 0xffff0000u);
    float s = 0.f;
#pragma unroll
    for (int j = 0; j < 8; ++j) s += v[j];
    const float mu = wave_sum(s) * (1.f / 512.f); float q = 0.f;
#pragma unroll
    for (int j = 0; j < 8; ++j) { const float d = v[j] - mu; q += d * d; }
    const float rstd = rsqrtf(wave_sum(q) * (1.f / 512.f) + EPS);
    if (lane == 0) { st[row * 2] = mu; st[row * 2 + 1] = rstd; }
}
__global__ void __launch_bounds__(256) k_sgu_naive(const bf16_t* __restrict__ gu, const bf16_t* __restrict__ gv, const float* __restrict__ st, const bf16_t* __restrict__ Wm, const float* __restrict__ b_s,
                                                   const float* __restrict__ g_sgu, const float* __restrict__ beta, bf16_t* __restrict__ out) {
    const int c = blockIdx.x * 256 + threadIdx.x, t = blockIdx.y, tt = t & 127, t0 = t - tt, g = c >> 7;
    const float gam = g_sgu[c], bet = beta[c];
    float sv = b_s[g * 128 + tt];
    for (int s = 0; s <= tt; ++s) { const float v = (bf2f(gv[(size_t)(t0 + s) * 512 + c]) - st[(t0 + s) * 2]) * st[(t0 + s) * 2 + 1] * gam + bet; sv += bf2f(Wm[(g * 128 + tt) * 128 + s]) * v; }
    out[(size_t)t * 512 + c] = f2bf(bf2f(gu[(size_t)t * 512 + c]) * sv);
}
__global__ void __launch_bounds__(256) k_merge_naive(const bf16_t* __restrict__ yag, const bf16_t* __restrict__ sgu, const bf16_t* __restrict__ o, const bf16_t* __restrict__ WaT, const bf16_t* __restrict__ WbT,
                                                     const bf16_t* __restrict__ WcT, const bf16_t* __restrict__ gates, bf16_t* __restrict__ merged) {
    const int n = blockIdx.x * 64 + (threadIdx.x & 63), m = blockIdx.y * 4 + (threadIdx.x >> 6);
    const float ya = dotrow(yag + (size_t)m * 512, WaT + (size_t)n * 512, 512), yb = dotrow(sgu + (size_t)m * 512, WbT + (size_t)n * 512, 512), yc = dotrow(o + (size_t)m * 512, WcT + (size_t)n * 512, 512);
    const bf16_t* gr = gates + (size_t)m * 3072 + n;
    merged[(size_t)m * D + n] = f2bf(bf2f(gr[0]) * ya + bf2f(gr[1024]) * yb + bf2f(gr[2048]) * yc);
}
__global__ void __launch_bounds__(256) k_ffnup_naive(const bf16_t* __restrict__ x1b, const bf16_t* __restrict__ WguT, const float* __restrict__ ss1, bf16_t* __restrict__ act) {
    const int j = blockIdx.x * 64 + (threadIdx.x & 63), m = blockIdx.y * 4 + (threadIdx.x >> 6);
    const int r0 = 256 * (j >> 7) + (j & 127);
    const float G = dotrow(x1b + (size_t)m * D, WguT + (size_t)r0 * D, D), U = dotrow(x1b + (size_t)m * D, WguT + (size_t)(r0 + 128) * D, D);
    const float rs = rsqrtf(ss1[m] * (1.f / D) + EPS), gg = rs * G;
    act[(size_t)m * DFF + j] = f2bf(gg * sigm(gg) * (rs * U));
}
__global__ void __launch_bounds__(512) k_rowss(const float* __restrict__ x, float* __restrict__ ss) {
    const int row = blockIdx.x * 8 + (threadIdx.x >> 6), lane = threadIdx.x & 63;
    const float4* xr = (const float4*)(x + (size_t)row * D) + lane; float s = 0.f;
#pragma unroll
    for (int j = 0; j < 4; ++j) { const float4 v = xr[64 * j]; s += v.x * v.x + v.y * v.y + v.z * v.z + v.w * v.w; }
    s = wave_sum(s); if (lane == 0) ss[row] = s;
}
__global__ void __launch_bounds__(256) k_final(float* __restrict__ x, const float* __restrict__ ss, const float* __restrict__ g) {
    const size_t i = (size_t)blockIdx.x * 256 + threadIdx.x; const int row = (int)(i >> 8), c4 = (int)(i & 255);
    const float rs = rsqrtf(ss[row] * (1.f / D) + EPS);
    float4 v = ((float4*)x)[i]; const float4 gg = ((const float4*)g)[c4];
    v.x *= rs * gg.x; v.y *= rs * gg.y; v.z *= rs * gg.z; v.w *= rs * gg.w; ((float4*)x)[i] = v;
}

#define LAS __attribute__((address_space(3)))
typedef short bf16x8 __attribute__((ext_vector_type(8)));
typedef float f32x4 __attribute__((ext_vector_type(4)));
typedef float f32x2 __attribute__((ext_vector_type(2)));
typedef unsigned u32x4 __attribute__((ext_vector_type(4)));
typedef unsigned u32x2 __attribute__((ext_vector_type(2)));
typedef __bf16 bf16x2_t __attribute__((ext_vector_type(2)));

constexpr int NWAVES = 8, NTHREADS = 512;
constexpr int BM = 256, BK = 64, HALF = 128, HTB = HALF * BK * 2, NXCD = 8, WGM = 8;
constexpr int RING_BYTES = 131072, LDS_BYTES = 147456, LDSCTL_OFF = LDS_BYTES - 512;
constexpr int CW_BAR = 4096;
enum { W_PREP = 1, W_INPROJ = 2, W_KV = 4, W_S5L = 8, W_SGU = 16, W_S5Y = 32, W_ATTN = 64, W_GLU = 128, W_MERGE = 256, W_WOUT = 512, W_FFNUP = 1024, W_FFNDOWN = 2048, W_FINAL = 4096, W_ALL = 8191 };

#define LDS_WAIT() asm volatile("s_waitcnt lgkmcnt(0)" ::: "memory")
#define VM_WAIT() asm volatile("s_waitcnt vmcnt(0)" ::: "memory")
__device__ __forceinline__ unsigned cvtpk(float lo, float hi) { f32x2 v = {lo, hi}; bf16x2_t b = __builtin_convertvector(v, bf16x2_t); return __builtin_bit_cast(unsigned, b); }
__device__ __forceinline__ u32x4 pack8(const f32x4 a, const f32x4 b) { u32x4 w; w.x = cvtpk(a[0], a[1]); w.y = cvtpk(a[2], a[3]); w.z = cvtpk(b[0], b[1]); w.w = cvtpk(b[2], b[3]); return w; }
__device__ __forceinline__ f32x4 unpk_lo(const u32x4 w) { return (f32x4){__uint_as_float(w.x << 16), __uint_as_float(w.x & 0xffff0000u), __uint_as_float(w.y << 16), __uint_as_float(w.y & 0xffff0000u)}; }
__device__ __forceinline__ f32x4 unpk_hi(const u32x4 w) { return (f32x4){__uint_as_float(w.z << 16), __uint_as_float(w.z & 0xffff0000u), __uint_as_float(w.w << 16), __uint_as_float(w.w & 0xffff0000u)}; }
__device__ __forceinline__ float sigm_f(float x) { return __builtin_amdgcn_rcpf(1.f + __builtin_amdgcn_exp2f(-1.4426950408889634f * x)); }
__device__ __forceinline__ float gelu_f(float x) { const float u2 = 1.5957691216057308f * (x + 0.044715f * x * x * x); return x * sigm_f(u2); }
__device__ __forceinline__ f32x4 gelu4(const f32x4 v) { return (f32x4){gelu_f(v[0]), gelu_f(v[1]), gelu_f(v[2]), gelu_f(v[3])}; }
__device__ __forceinline__ f32x4 sigm4(const f32x4 v) { return (f32x4){sigm_f(v[0]), sigm_f(v[1]), sigm_f(v[2]), sigm_f(v[3])}; }
__device__ __forceinline__ f32x4 rcp4(const f32x4 v) { return (f32x4){__builtin_amdgcn_rcpf(v[0]), __builtin_amdgcn_rcpf(v[1]), __builtin_amdgcn_rcpf(v[2]), __builtin_amdgcn_rcpf(v[3])}; }

#define XB_TMO      128
#define XB_XCNT(j)  (256  + 64 * (j))
#define XB_XSUB(j)  (1280 + 64 * (j))
#define XB_XGEN(j)  (2304 + 64 * (j))
#define XB_TOP      3328
#define XB_TOPGEN   3392
#define XCD_BAR_WORDS 3456
#define XB_SPIN_CAP (1u << 18)
__device__ __forceinline__ unsigned xb_ld(unsigned* p)              { return __hip_atomic_load(p, __ATOMIC_RELAXED, __HIP_MEMORY_SCOPE_AGENT); }
__device__ __forceinline__ unsigned xb_add(unsigned* p, unsigned v) { return __hip_atomic_fetch_add(p, v, __ATOMIC_RELAXED, __HIP_MEMORY_SCOPE_AGENT); }
__device__ __forceinline__ unsigned xb_xcc_id() { return (unsigned)__builtin_amdgcn_s_getreg((3 << 11) | 20) & 0xFu; }
#define XB_SPIN(cond, bar) do { unsigned _sp = 0; while (cond) { __builtin_amdgcn_s_sleep(1); \
    if ((++_sp & 255u) == 0u) { if (xb_ld(&(bar)[XB_TMO])) break; if (_sp > XB_SPIN_CAP) { atomicAdd(&(bar)[XB_TMO], 1u); break; } } } } while (0)
struct XcdBarrier { unsigned* bar; unsigned x; volatile LAS unsigned* st; };
__device__ __forceinline__ XcdBarrier xcd_barrier_post(unsigned* bar, volatile LAS unsigned* st) {
    XcdBarrier b; b.bar = bar; b.x = xb_xcc_id(); b.st = st;
    if (threadIdx.x == 0) (void)xb_add(&bar[XB_XCNT(b.x)], 1u);
    return b;
}
__device__ __forceinline__ void xcd_barrier_complete(unsigned* bar, unsigned x, unsigned& nloc, unsigned& nx) {
    const unsigned G = gridDim.x * gridDim.y * gridDim.z;
    unsigned sum, cnt, mine, sp = 0u;
    for (;;) {
        sum = 0u; cnt = 0u; mine = 0u;
#pragma unroll
        for (unsigned j = 0; j < 16; ++j) { const unsigned c = xb_ld(&bar[XB_XCNT(j)]); sum += c; cnt += (c > 0u) ? 1u : 0u; mine = (j == x) ? c : mine; }
        if (sum == G) break;
        __builtin_amdgcn_s_sleep(1);
        if ((++sp & 255u) == 0u) { if (xb_ld(&bar[XB_TMO])) break; if (sp > XB_SPIN_CAP) { atomicAdd(&bar[XB_TMO], 1u); break; } }
    }
    nloc = mine > 0u ? mine : 1u; nx = cnt > 0u ? cnt : 1u;
}
__device__ __forceinline__ void xcd_barrier(const XcdBarrier& b) {
    asm volatile("s_waitcnt vmcnt(0)" ::: "memory");
    __syncthreads();
    if (threadIdx.x == 0) {
        unsigned* bar = b.bar;
        __builtin_amdgcn_s_waitcnt(0);
        unsigned nloc = b.st[0], nx = b.st[1];
        if (nloc == 0u) { xcd_barrier_complete(bar, b.x, nloc, nx); b.st[0] = nloc; b.st[1] = nx; }
        const unsigned old = xb_add(&bar[XB_XSUB(b.x)], 1u);
        const unsigned gen = old / nloc;
        if (old + 1u == (gen + 1u) * nloc) {
            __builtin_amdgcn_fence(__ATOMIC_RELEASE, "agent");
            asm volatile("s_waitcnt vmcnt(0)" ::: "memory");
            const unsigned og = xb_add(&bar[XB_TOP], 1u);
            const unsigned tg = og / nx;
            if (og + 1u == (tg + 1u) * nx) xb_add(&bar[XB_TOPGEN], 1u);
            else XB_SPIN(xb_ld(&bar[XB_TOPGEN]) == tg, bar);
            __builtin_amdgcn_fence(__ATOMIC_ACQUIRE, "agent");
            xb_add(&bar[XB_XGEN(b.x)], 1u);
            asm volatile("s_waitcnt vmcnt(0)" ::: "memory");
        } else {
            XB_SPIN(xb_ld(&bar[XB_XGEN(b.x)]) == gen, bar);
            __builtin_amdgcn_fence(__ATOMIC_ACQUIRE, "agent");
            asm volatile("s_waitcnt vmcnt(0)" ::: "memory");
        }
    }
    __syncthreads();
}

__host__ __device__ __forceinline__ int lds_byte(int r, int c) { const int st = (r >> 4) * 2 + (c >> 5), rr = r & 15, cc = c & 31, ob = rr * 64 + cc * 2; return st * 1024 + (ob ^ (((ob >> 9) & 1) << 5)); }
__host__ __device__ __forceinline__ void stage_rc(int b, int& R, int& C) { const int st = b / 1024, sb = b % 1024, swz = sb ^ (((sb >> 9) & 1) << 5); R = (st >> 1) * 16 + swz / 64; C = (st & 1) * 32 + (swz % 64) / 2; }
__host__ __device__ __forceinline__ int perm32(int rho) { const int n = rho >> 4, i = rho & 15; return 8 * (i >> 2) + 4 * n + (i & 3); }
struct Unit { const char* a; const char* b; int pm, pn, sub; };

struct TileOrder {
    int nM, nN, nwg, G, c; const char* A; const char* B; size_t ta, tb;
    __device__ __forceinline__ void init(int M, int N, int G_, int c_, const void* A_, int lda, const void* B_, int ldb) { nM = M / BM; nN = N / BM; nwg = nM * nN; G = G_; c = c_; A = (const char*)A_; B = (const char*)B_; ta = (size_t)BM * lda * 2; tb = (size_t)BM * ldb * 2; }
    __device__ __forceinline__ bool tile(long L, int& pm, int& pn) const {
        if (L >= nwg) return false;
        int wgid = (int)L; { const int q = nwg / NXCD, r = nwg % NXCD, xcd = wgid % NXCD, off = wgid / NXCD; wgid = (xcd < r ? xcd * (q + 1) : r * (q + 1) + (xcd - r) * q) + off; }
        const int nig = WGM * nN, gid = wgid / nig, fm = gid * WGM, gsz = (nM - fm) < WGM ? (nM - fm) : WGM;
        pm = fm + ((wgid % nig) % gsz); pn = (wgid % nig) / gsz; return true;
    }
    __device__ __forceinline__ bool next(int i, Unit& u) const { if (!tile((long)i * G + c, u.pm, u.pn)) return false; u.a = A + (size_t)u.pm * ta; u.b = B + (size_t)u.pn * tb; u.sub = 0; return true; }
};

template <class Epi, class Sched>
__device__ __forceinline__ void gemm_phase(LAS unsigned char* lds, const int lda, const int ldb, const int nt, const Sched S, const Epi E) {
    const int tid = threadIdx.x, wid = __builtin_amdgcn_readfirstlane(tid >> 6), lane = tid & 63, wr = wid >> 2, wc = wid & 3, fr = lane & 15, fq = lane >> 4;
    unsigned voffA[2], voffB[2];
#pragma unroll
    for (int i = 0; i < 2; ++i) { int R, C; stage_rc(tid * 16 + i * 8192, R, C); const int Rb = Epi::PERM ? ((R & ~31) + perm32(R & 31)) : R;
        voffA[i] = (unsigned)(R * lda + C) * 2u; voffB[i] = (unsigned)(Rb * ldb + C) * 2u; }
    const size_t kstep = (size_t)(BK * 2);
    const size_t hstepA = (size_t)HALF * lda * 2, hstepB = (size_t)HALF * ldb * 2;
    const unsigned ldsw = (unsigned)wid * 1024u;
    const int aoff = lds_byte(wr * 64 + fr, fq * 8), boff = lds_byte(wc * 32 + fr, fq * 8);
#define PG8_SA(b, h) (((b) * 2 + (h)) * HTB)
#define PG8_SB(b, h) ((4 + (b) * 2 + (h)) * HTB)
#define PG8_STAGE(bufoff, gbase, voff) do { _Pragma("unroll") for (int _i = 0; _i < 2; ++_i) \
        __builtin_amdgcn_global_load_lds((const unsigned*)((const char*)(gbase) + (voff)[_i]), (LAS unsigned*)(lds + (bufoff) + ldsw + _i * 8192), 16, 0, 0); } while (0)
#define PG8_LDA(dst, b, h) do { _Pragma("unroll") for (int m = 0; m < 4; ++m) _Pragma("unroll") for (int k = 0; k < 2; ++k) dst[m][k] = *(const LAS bf16x8*)(lds + PG8_SA(b, h) + aoff + m * 2048 + k * 1024); } while (0)
#define PG8_LDB(dst, b, h) do { _Pragma("unroll") for (int n = 0; n < 2; ++n) _Pragma("unroll") for (int k = 0; k < 2; ++k) dst[n][k] = *(const LAS bf16x8*)(lds + PG8_SB(b, h) + boff + n * 2048 + k * 1024); } while (0)
#define PG8_MMA(ai, bj, At, Bt) do { __builtin_amdgcn_s_setprio(1); _Pragma("unroll") for (int m = 0; m < 4; ++m) _Pragma("unroll") for (int n = 0; n < 2; ++n) _Pragma("unroll") for (int k = 0; k < 2; ++k) \
        acc[ai][bj][m][n] = __builtin_amdgcn_mfma_f32_16x16x32_bf16(Bt[n][k], At[m][k], acc[ai][bj][m][n], 0, 0, 0); __builtin_amdgcn_s_setprio(0); } while (0)
#define PG8_WAIT_V(n) asm volatile("s_waitcnt vmcnt(" #n ")" ::: "memory")
#define PG8_WAIT_L(n) asm volatile("s_waitcnt lgkmcnt(" #n ")" ::: "memory")
#define PG8_BAR __builtin_amdgcn_s_barrier()
#define PG8_SCHED __builtin_amdgcn_sched_barrier(0)
    Unit cur, nxt; int ui = 0;
    if (!S.next(0, cur)) return;
    f32x4 acc[2][2][4][2];
#pragma unroll
    for (int a = 0; a < 2; ++a)
#pragma unroll
        for (int b = 0; b < 2; ++b)
#pragma unroll
            for (int m = 0; m < 4; ++m)
#pragma unroll
                for (int n = 0; n < 2; ++n) acc[a][b][m][n] = (f32x4){0.f, 0.f, 0.f, 0.f};
    bf16x8 At[4][2], B0[2][2], B1[2][2];
    const char* cA = cur.a; const char* cB = cur.b;
    PG8_STAGE(PG8_SB(0, 0), cB, voffB); PG8_STAGE(PG8_SB(0, 1), cB + hstepB, voffB); PG8_STAGE(PG8_SA(0, 0), cA, voffA); PG8_STAGE(PG8_SA(0, 1), cA + hstepA, voffA);
    if (wr == 1) PG8_BAR;
    PG8_WAIT_V(2); PG8_BAR;
    PG8_STAGE(PG8_SB(1, 0), cB + kstep, voffB); PG8_STAGE(PG8_SA(1, 0), cA + kstep, voffA); PG8_STAGE(PG8_SB(1, 1), cB + hstepB + kstep, voffB);
    PG8_WAIT_V(6); PG8_BAR;
    for (;;) {
        const bool has_next = S.next(ui + 1, nxt);
        const char* nA = has_next ? nxt.a : cA; const char* nB = has_next ? nxt.b : cB;
#pragma unroll 1
        for (int t = 0; t < nt; t += 2) {
            const bool last = (t == nt - 2);
            const char* a1 = cA + (size_t)(t + 1) * kstep;
            const char* a2 = last ? nA : cA + (size_t)(t + 2) * kstep; const char* b2 = last ? nB : cB + (size_t)(t + 2) * kstep;
            const char* a3 = a2 + kstep; const char* b3 = b2 + kstep;
            PG8_LDB(B0, 0, 0); PG8_LDB(B1, 0, 1); PG8_SCHED; PG8_LDA(At, 0, 0); PG8_STAGE(PG8_SA(1, 1), a1 + hstepA, voffA);
            PG8_WAIT_V(8); PG8_WAIT_L(0); PG8_BAR; PG8_MMA(0, 0, At, B0); PG8_MMA(0, 1, At, B1); PG8_BAR; PG8_SCHED;
            PG8_LDA(At, 0, 1); PG8_STAGE(PG8_SB(0, 0), b2, voffB); PG8_STAGE(PG8_SB(0, 1), b2 + hstepB, voffB); PG8_STAGE(PG8_SA(0, 0), a2, voffA);
            PG8_WAIT_V(8); PG8_WAIT_L(0); PG8_BAR; PG8_MMA(1, 0, At, B0); PG8_MMA(1, 1, At, B1); PG8_BAR; PG8_SCHED;
            PG8_LDB(B0, 1, 0); PG8_LDB(B1, 1, 1); PG8_SCHED; PG8_LDA(At, 1, 0); PG8_STAGE(PG8_SA(0, 1), a2 + hstepA, voffA);
            PG8_WAIT_V(8); PG8_WAIT_L(0); PG8_BAR; PG8_MMA(0, 0, At, B0); PG8_MMA(0, 1, At, B1); PG8_BAR; PG8_SCHED;
            PG8_LDA(At, 1, 1); PG8_STAGE(PG8_SB(1, 0), b3, voffB); PG8_STAGE(PG8_SB(1, 1), b3 + hstepB, voffB); PG8_STAGE(PG8_SA(1, 0), a3, voffA);
            PG8_WAIT_V(8); PG8_WAIT_L(0); PG8_BAR; PG8_MMA(1, 0, At, B0); PG8_MMA(1, 1, At, B1); PG8_BAR; PG8_SCHED;
        }
        if (wr == 0) PG8_BAR;
        const bool reset = E(acc, cur, wr, wc, fr, fq);
        if (!has_next) break;
        if (reset) {
#pragma unroll
            for (int a = 0; a < 2; ++a)
#pragma unroll
                for (int b = 0; b < 2; ++b)
#pragma unroll
                    for (int m = 0; m < 4; ++m)
#pragma unroll
                        for (int n = 0; n < 2; ++n) acc[a][b][m][n] = (f32x4){0.f, 0.f, 0.f, 0.f};
        }
        cur = nxt; cA = nA; cB = nB; ++ui;
        if (wr == 1) PG8_BAR;
    }
    PG8_WAIT_V(0);
    PG8_BAR;
#undef PG8_SA
#undef PG8_SB
#undef PG8_STAGE
#undef PG8_LDA
#undef PG8_LDB
#undef PG8_MMA
#undef PG8_WAIT_V
#undef PG8_WAIT_L
#undef PG8_BAR
#undef PG8_SCHED
}

typedef f32x4 (&AccRef)[2][2][4][2];
#define EPI_LOOP_AM _Pragma("unroll") for (int ai = 0; ai < 2; ++ai) _Pragma("unroll") for (int m = 0; m < 4; ++m)
struct EpiInprojM {
    static constexpr bool PERM = true;
    bf16_t *Ag, *gu, *gv, *q, *gates; const float* b_gate;
    __device__ __forceinline__ bool operator()(AccRef acc, const Unit& u, int wr, int wc, int fr, int fq) const {
        const int row0 = u.pm * BM + wr * 64 + fr, cl = wc * 32 + 8 * fq, pn = u.pn;
        if (pn < 2) {
            EPI_LOOP_AM { const int row = row0 + ai * HALF + m * 16;
#pragma unroll
                for (int bj = 0; bj < 2; ++bj) { const int c = pn * 256 + bj * HALF + cl, g = c >> 4, hp = c & 15;
                    *(u32x4*)(Ag + ((size_t)(g * NCH + (row >> 4)) * KE + (row & 15) * 16 + hp)) = pack8(acc[ai][bj][m][0], acc[ai][bj][m][1]); } }
        } else if (pn < 6) {
            bf16_t* base = (pn < 4 ? gu : gv) + (pn & 1) * 256 + cl;
            EPI_LOOP_AM { const int row = row0 + ai * HALF + m * 16;
#pragma unroll
                for (int bj = 0; bj < 2; ++bj) *(u32x4*)(base + (size_t)row * 512 + bj * HALF) = pack8(gelu4(acc[ai][bj][m][0]), gelu4(acc[ai][bj][m][1])); }
        } else if (pn < 8) {
            bf16_t* base = q + (pn & 1) * 256 + cl;
            EPI_LOOP_AM { const int row = row0 + ai * HALF + m * 16;
#pragma unroll
                for (int bj = 0; bj < 2; ++bj) *(u32x4*)(base + (size_t)row * 512 + bj * HALF) = pack8(acc[ai][bj][m][0] * 0.08838834764831845f, acc[ai][bj][m][1] * 0.08838834764831845f); }
        } else {
            const int cg = (pn - 8) * 256 + cl;
            f32x4 bv[2][2];
#pragma unroll
            for (int bj = 0; bj < 2; ++bj) { bv[bj][0] = *(const f32x4*)(b_gate + cg + bj * HALF); bv[bj][1] = *(const f32x4*)(b_gate + cg + bj * HALF + 4); }
            EPI_LOOP_AM { const int row = row0 + ai * HALF + m * 16;
#pragma unroll
                for (int bj = 0; bj < 2; ++bj) *(u32x4*)(gates + (size_t)row * 3072 + cg + bj * HALF) = pack8(sigm4(acc[ai][bj][m][0] + bv[bj][0]), sigm4(acc[ai][bj][m][1] + bv[bj][1])); }
        }
        return true;
    }
};
struct EpiKVM {
    static constexpr bool PERM = true;
    bf16_t *kb, *vT;
    __device__ __forceinline__ bool operator()(AccRef acc, const Unit& u, int wr, int wc, int fr, int fq) const {
        const int row0 = u.pm * BM + wr * 64 + fr, cl = wc * 32 + 8 * fq, pn = u.pn;
        if (pn < 2) {
            EPI_LOOP_AM { const int row = row0 + ai * HALF + m * 16;
#pragma unroll
                for (int bj = 0; bj < 2; ++bj) *(u32x4*)(kb + (size_t)row * 512 + pn * 256 + bj * HALF + cl) = pack8(acc[ai][bj][m][0], acc[ai][bj][m][1]); }
        } else {
            EPI_LOOP_AM { const int row = row0 + ai * HALF + m * 16, b = row >> 8, mm = row & 255;
#pragma unroll
                for (int bj = 0; bj < 2; ++bj) { const int hd = (pn - 2) * 256 + bj * HALF + cl; bf16_t* dst = vT + ((size_t)b * 512 + hd) * 256 + mm;
#pragma unroll
                    for (int n = 0; n < 2; ++n)
#pragma unroll
                        for (int j = 0; j < 4; ++j) dst[(size_t)(n * 4 + j) * 256] = (bf16_t)(cvtpk(acc[ai][bj][m][n][j], 0.f) & 0xffffu); } }
        }
        return true;
    }
};
struct EpiS5YM {
    static constexpr bool PERM = true;
    bf16_t* yap;
    __device__ __forceinline__ bool operator()(AccRef acc, const Unit& u, int wr, int wc, int fr, int fq) const {
        const int g = u.pm >> 2, mch0 = (u.pm & 3) * BM + wr * 64 + fr, cl = wc * 32 + 8 * fq;
        EPI_LOOP_AM { const int mch = mch0 + ai * HALF + m * 16;
#pragma unroll
            for (int bj = 0; bj < 2; ++bj) { const int n = bj * HALF + cl, tau = n >> 4, hh = n & 15; const size_t tg = (size_t)mch * 16 + tau;
                *(u32x4*)(yap + tg * 512 + g * 16 + hh) = pack8(gelu4(acc[ai][bj][m][0]), gelu4(acc[ai][bj][m][1])); } }
        return true;
    }
};
struct EpiGluM {
    static constexpr bool PERM = true;
    const bf16_t* yap; const float* b_glu; bf16_t* yag;
    __device__ __forceinline__ bool operator()(AccRef acc, const Unit& u, int wr, int wc, int fr, int fq) const {
        const int row0 = u.pm * BM + wr * 64 + fr, c0 = u.pn * 256 + wc * 32 + 8 * fq;
        f32x4 bv[2][2];
#pragma unroll
        for (int bj = 0; bj < 2; ++bj) { bv[bj][0] = *(const f32x4*)(b_glu + c0 + bj * HALF); bv[bj][1] = *(const f32x4*)(b_glu + c0 + bj * HALF + 4); }
        EPI_LOOP_AM { const size_t ro = (size_t)(row0 + ai * HALF + m * 16) * 512 + c0;
#pragma unroll
            for (int bj = 0; bj < 2; ++bj) { const u32x4 yv = *(const u32x4*)(yap + ro + bj * HALF);
                *(u32x4*)(yag + ro + bj * HALF) = pack8(unpk_lo(yv) * sigm4(acc[ai][bj][m][0] + bv[bj][0]), unpk_hi(yv) * sigm4(acc[ai][bj][m][1] + bv[bj][1])); } }
        return true;
    }
};
struct EpiMergeM {
    static constexpr bool PERM = true;
    const bf16_t* gates; bf16_t* merged;
    __device__ __forceinline__ bool operator()(AccRef acc, const Unit& u, int wr, int wc, int fr, int fq) const {
        const int row0 = u.pm * BM + wr * 64 + fr, c0 = u.pn * 256 + wc * 32 + 8 * fq, sub = u.sub;
        EPI_LOOP_AM { const int row = row0 + ai * HALF + m * 16; const bf16_t* gr = gates + (size_t)row * 3072 + c0;
#pragma unroll
            for (int bj = 0; bj < 2; ++bj) {
                if (sub < 2) { const u32x4 nu = *(const u32x4*)(gr + sub * 1024 + bj * HALF), de = *(const u32x4*)(gr + (sub + 1) * 1024 + bj * HALF);
                    acc[ai][bj][m][0] = acc[ai][bj][m][0] * (unpk_lo(nu) * rcp4(unpk_lo(de))); acc[ai][bj][m][1] = acc[ai][bj][m][1] * (unpk_hi(nu) * rcp4(unpk_hi(de))); }
                else { const u32x4 g2 = *(const u32x4*)(gr + 2048 + bj * HALF);
                    *(u32x4*)(merged + (size_t)row * D + c0 + bj * HALF) = pack8(acc[ai][bj][m][0] * unpk_lo(g2), acc[ai][bj][m][1] * unpk_hi(g2)); } } }
        return sub == 2;
    }
};
struct EpiResM {
    static constexpr bool PERM = false;
    const float* base; float* out; bf16_t* ob; float* ss;
    __device__ __forceinline__ bool operator()(AccRef acc, const Unit& u, int wr, int wc, int fr, int fq) const {
        const int row0 = u.pm * BM + wr * 64 + fr, c0 = u.pn * 256 + wc * 32 + 4 * fq;
        EPI_LOOP_AM { const int row = row0 + ai * HALF + m * 16; const size_t ro = (size_t)row * D + c0; float s = 0.f;
#pragma unroll
            for (int bj = 0; bj < 2; ++bj)
#pragma unroll
                for (int n = 0; n < 2; ++n) { const f32x4 v = *(const f32x4*)(base + ro + bj * HALF + n * 16) + acc[ai][bj][m][n];
                    *(f32x4*)(out + ro + bj * HALF + n * 16) = v; s += (v[0] * v[0] + v[1] * v[1]) + (v[2] * v[2] + v[3] * v[3]);
                    if (ob) { u32x2 w; w.x = cvtpk(v[0], v[1]); w.y = cvtpk(v[2], v[3]); *(u32x2*)(ob + ro + bj * HALF + n * 16) = w; } }
            s += __shfl_xor(s, 16); s += __shfl_xor(s, 32);
            if (fq == 0) __hip_atomic_fetch_add(ss + row, s, __ATOMIC_RELAXED, __HIP_MEMORY_SCOPE_AGENT); }
        return true;
    }
};
struct EpiFfnUpM {
    static constexpr bool PERM = true;
    const float* ss1; bf16_t* act;
    __device__ __forceinline__ bool operator()(AccRef acc, const Unit& u, int wr, int wc, int fr, int fq) const {
        const int row0 = u.pm * BM + wr * 64 + fr, c0 = u.pn * 128 + wc * 32 + 8 * fq;
        EPI_LOOP_AM { const int row = row0 + ai * HALF + m * 16; const float rs = rsqrtf(ss1[row] * (1.f / D) + EPS);
            f32x4 o[2];
#pragma unroll
            for (int n = 0; n < 2; ++n) { const f32x4 gg = acc[ai][0][m][n] * rs, uu = acc[ai][1][m][n] * rs; o[n] = gg * sigm4(gg) * uu; }
            *(u32x4*)(act + (size_t)row * DFF + c0) = pack8(o[0], o[1]); }
        return true;
    }
};

struct MergeOrder { TileOrder T; const char *a0, *b0; long da1, da2, db1, db2; size_t ta, tb;
    __device__ __forceinline__ bool next(int i, Unit& u) const { const int j = i / 3, s = i - 3 * j; if (!T.tile((long)j * T.G + T.c, u.pm, u.pn)) return false;
        const long s1 = (s == 1) ? 1 : 0, s2 = (s == 2) ? 1 : 0;
        u.a = a0 + s1 * da1 + s2 * da2 + (size_t)u.pm * ta; u.b = b0 + s1 * db1 + s2 * db2 + (size_t)u.pn * tb; u.sub = s; return true; } };
struct S5YOrder { int G, c; const char* Ag; const char* Km;
    __device__ __forceinline__ bool next(int i, Unit& u) const { const int L = i * G + c; if (L >= 128) return false; const int g = L >> 2, rt = L & 3;
        u.a = Ag + ((size_t)g * NCH + 256 * rt) * KE * 2; u.b = Km + (size_t)g * 256 * KE * 2; u.pm = L; u.pn = 0; u.sub = 0; return true; } };
struct KvOrder { int G, c; const char* A; const char* B;
    __device__ __forceinline__ bool next(int i, Unit& u) const { const int first = G >= 32 ? G - 32 : 0, str = G >= 32 ? 32 : G; if (c < first) return false; const int L = i * str + (c - first); if (L >= 32) return false;
        u.pm = L >> 2; u.pn = L & 3; u.a = A + (size_t)u.pm * BM * D * 2; u.b = B + (size_t)u.pn * BM * D * 2; u.sub = 0; return true; } };

__device__ __forceinline__ void p0_transpose_item(const float* __restrict__ W, int K, int N, bf16_t* __restrict__ WT, int ldt, const float* __restrict__ scale, int mode, LAS float* scr, int item, int lane) {
    const int nblk = N / 32, kb = item / nblk, nb = item % nblk, k0 = 64 * kb, n0 = 32 * nb;
    float tv[32];
#pragma unroll
    for (int i = 0; i < 32; ++i) tv[i] = W[(size_t)(k0 + 2 * i + (lane >> 5)) * N + n0 + (lane & 31)];
#pragma unroll
    for (int i = 0; i < 32; ++i) { const int kk = 2 * i + (lane >> 5); float v = tv[i]; if (scale) v *= scale[k0 + kk]; scr[kk * 33 + (lane & 31)] = v; }
    LDS_WAIT(); asm volatile("" ::: "memory");
    const int c = lane & 7;
#pragma unroll
    for (int j = 0; j < 4; ++j) { const int n = (lane >> 3) + 8 * j; const LAS float* s = scr + (8 * c) * 33 + n;
        u32x4 o; o.x = cvtpk(s[0 * 33], s[1 * 33]); o.y = cvtpk(s[2 * 33], s[3 * 33]); o.z = cvtpk(s[4 * 33], s[5 * 33]); o.w = cvtpk(s[6 * 33], s[7 * 33]);
        const int ng = n0 + n, drow = mode == 0 ? ng : 256 * (ng >> 7) + 128 * (mode - 1) + (ng & 127);
        *(u32x4*)(WT + (size_t)drow * ldt + k0 + 8 * c) = o; }
    LDS_WAIT(); asm volatile("" ::: "memory");
}
template <int NR> __device__ __forceinline__ void rms_rows_bf16(const float* __restrict__ xrow, const float* __restrict__ g, bf16_t* __restrict__ orow, int lane) {
    f32x4 v[NR][4]; float s[NR];
#pragma unroll
    for (int r = 0; r < NR; ++r)
#pragma unroll
        for (int j = 0; j < 4; ++j) v[r][j] = ((const f32x4*)(xrow + (size_t)r * D))[64 * j + lane];
#pragma unroll
    for (int r = 0; r < NR; ++r) { s[r] = 0.f;
#pragma unroll
        for (int j = 0; j < 4; ++j) s[r] += (v[r][j][0] * v[r][j][0] + v[r][j][1] * v[r][j][1]) + (v[r][j][2] * v[r][j][2] + v[r][j][3] * v[r][j][3]); }
#pragma unroll
    for (int o = 1; o < 64; o <<= 1)
#pragma unroll
        for (int r = 0; r < NR; ++r) s[r] += __shfl_xor(s[r], o);
#pragma unroll
    for (int j = 0; j < 4; ++j) { const f32x4 gg = ((const f32x4*)g)[64 * j + lane];
#pragma unroll
        for (int r = 0; r < NR; ++r) { const float rs = rsqrtf(s[r] * (1.f / D) + EPS); const f32x4 o = v[r][j] * rs * gg; u32x2 w; w.x = cvtpk(o[0], o[1]); w.y = cvtpk(o[2], o[3]); ((u32x2*)(orow + (size_t)r * D))[64 * j + lane] = w; } }
}

struct MArgs { const float* in[30]; float* out; unsigned char* ws; int mask, bars; };

__device__ __forceinline__ void prep_phase(const MArgs& a, LAS unsigned char* lds, int G, int bx, int tid, int wave, int lane) {
    unsigned char* ws = a.ws;
    for (int blk = bx; blk < 256; blk += G) {
        const int g = blk >> 3, j = blk & 7;
        LAS float* E = (LAS float*)lds; LAS float* Bb = (LAS float*)(lds + 8704); LAS float* Kt = (LAS float*)(lds + 16896);
        if (tid < 64) {
            const int idx = g * 64 + tid;
            const double dt = (double)expf(a.in[7][g]), ar = a.in[5][idx], ai = a.in[6][idx];
            const double xm = ar * dt;
            double mag = 1.0; { double term = 1.0; for (int i = 1; i <= 12; ++i) { term *= xm / (double)i; mag += term; } }
            const double th = ai * dt, kq = __builtin_rint(th * 0.6366197723675814);
            const double r = __builtin_fma(-kq, 6.123233995736766e-17, __builtin_fma(-kq, 1.5707963267948966, th)), r2 = r * r;
            const double sr = r * (1.0 + r2 * (-1.0 / 6 + r2 * (1.0 / 120 + r2 * (-1.0 / 5040 + r2 * (1.0 / 362880 + r2 * (-1.0 / 39916800 + r2 * (1.0 / 6227020800.0)))))));
            const double cr = 1.0 + r2 * (-0.5 + r2 * (1.0 / 24 + r2 * (-1.0 / 720 + r2 * (1.0 / 40320 + r2 * (-1.0 / 3628800 + r2 * (1.0 / 479001600 + r2 * (-1.0 / 87178291200.0)))))));
            const int qd = ((int)kq) & 3;
            const double cs = (qd == 0) ? cr : (qd == 1) ? -sr : (qd == 2) ? -cr : sr, sn = (qd == 0) ? sr : (qd == 1) ? cr : (qd == 2) ? -sr : -cr;
            const double abr = mag * cs, abi = mag * sn;
            const double nr = abr - 1.0, den = ar * ar + ai * ai, fre = (nr * ar + abi * ai) / den, fim = (abi * ar - nr * ai) / den;
            double er = 1.0, ei = 0.0;
#pragma unroll 1
            for (int t = 0; t <= LC; ++t) { E[(tid * 17 + t) * 2] = (float)er; E[(tid * 17 + t) * 2 + 1] = (float)ei; const double n1 = er * abr - ei * abi, n2 = er * abi + ei * abr; er = n1; ei = n2; }
#pragma unroll 1
            for (int h = 0; h < 16; ++h) { const double br = a.in[8][idx * 16 + h], bi = a.in[9][idx * 16 + h]; Bb[(tid * 16 + h) * 2] = (float)(fre * br - fim * bi); Bb[(tid * 16 + h) * 2 + 1] = (float)(fre * bi + fim * br); }
        }
        __syncthreads();
        const float* cmr = a.in[10] + (size_t)g * 16 * 64; const float* cmi = a.in[11] + (size_t)g * 16 * 64;
#pragma unroll 1
        for (int i = 0; i < 8; ++i) {
            const int e = tid + 512 * i, tau = e >> 8, h = (e >> 4) & 15, hp = e & 15; float s = 0.f;
#pragma unroll 4
            for (int p = 0; p < 64; ++p) { const float er = E[(p * 17 + tau) * 2], ei = E[(p * 17 + tau) * 2 + 1], br = Bb[(p * 16 + hp) * 2], bi = Bb[(p * 16 + hp) * 2 + 1];
                s += cmr[h * 64 + p] * (er * br - ei * bi) - cmi[h * 64 + p] * (er * bi + ei * br); }
            if (tau == 0 && hp == h) s += a.in[12][g * 16 + h];
            Kt[e] = s;
        }
        __syncthreads();
        bf16_t* Km = (bf16_t*)(ws + WS_KMAT) + (size_t)g * 256 * KE; bf16_t* We = (bf16_t*)(ws + WS_WEND) + (size_t)g * 128 * 256;
#pragma unroll 1
        for (int i = 0; i < 24; ++i) {
            const int idx = tid + 512 * i, nl = idx / KE, k = idx - nl * KE, n = 32 * j + nl, to = n >> 4, h = n & 15; float val = 0.f;
            if (k < 256) { const int ti = k >> 4, hp = k & 15; if (ti <= to) val = Kt[(to - ti) * 256 + h * 16 + hp]; }
            else { const int pp = k - 256, p = pp & 63, im = pp >> 6; const float cr = cmr[h * 64 + p], ci = cmi[h * 64 + p], er = E[(p * 17 + to + 1) * 2], ei = E[(p * 17 + to + 1) * 2 + 1];
                val = im ? -(cr * ei + ci * er) : (cr * er - ci * ei); }
            Km[(size_t)n * KE + k] = f2bf(val);
        }
#pragma unroll 1
        for (int i = 0; i < 8; ++i) {
            const int idx = tid + 512 * i, ppl = idx >> 8, k = idx & 255, pp = 16 * j + ppl, p = pp & 63, im = pp >> 6, tau = k >> 4, hp = k & 15;
            const float er = E[(p * 17 + (LC - 1 - tau)) * 2], ei = E[(p * 17 + (LC - 1 - tau)) * 2 + 1], br = Bb[(p * 16 + hp) * 2], bi = Bb[(p * 16 + hp) * 2 + 1];
            We[(size_t)pp * 256 + k] = f2bf(im ? (er * bi + ei * br) : (er * br - ei * bi));
        }
        if (j == 0 && tid < 64) { float* a16 = (float*)(ws + WS_TABE) + (size_t)(g * 64 + tid) * 2; a16[0] = E[(tid * 17 + LC) * 2]; a16[1] = E[(tid * 17 + LC) * 2 + 1]; }
        __syncthreads();
    }
    LAS float* scr = (LAS float*)(lds + wave * 16384);
    const int gw = bx * NWAVES + wave, NGW = G * NWAVES;
    constexpr int I_IN = (D / 64) * (INW / 32), I_G = (D / 64) * (DFF / 32), I_D = (DFF / 64) * (D / 32), I_KV = (D / 64) * (1024 / 32), I_O = I_KV, I_ABC = (512 / 64) * (D / 32), I_GLU = (512 / 64) * (512 / 32);
    constexpr int NITEMS = I_IN + 2 * I_G + I_D + I_KV + I_O + 3 * I_ABC + I_GLU;
#pragma unroll 1
    for (int it = gw; it < NITEMS; it += NGW) {
        int r = it;
        if (r < I_IN) { p0_transpose_item(a.in[3], D, INW, (bf16_t*)(ws + WS_WIN), D, nullptr, 0, scr, r, lane); continue; } r -= I_IN;
        if (r < I_G) { p0_transpose_item(a.in[26], D, DFF, (bf16_t*)(ws + WS_WGU), D, a.in[25], 1, scr, r, lane); continue; } r -= I_G;
        if (r < I_G) { p0_transpose_item(a.in[27], D, DFF, (bf16_t*)(ws + WS_WGU), D, a.in[25], 2, scr, r, lane); continue; } r -= I_G;
        if (r < I_D) { p0_transpose_item(a.in[28], DFF, D, (bf16_t*)(ws + WS_WD), DFF, nullptr, 0, scr, r, lane); continue; } r -= I_D;
        if (r < I_KV) { p0_transpose_item(a.in[20], D, 1024, (bf16_t*)(ws + WS_WKV), D, nullptr, 0, scr, r, lane); continue; } r -= I_KV;
        if (r < I_O) { p0_transpose_item(a.in[24], D, D, (bf16_t*)(ws + WS_WOUT), D, nullptr, 0, scr, r, lane); continue; } r -= I_O;
        if (r < I_ABC) { p0_transpose_item(a.in[21], 512, D, (bf16_t*)(ws + WS_WA), 512, nullptr, 0, scr, r, lane); continue; } r -= I_ABC;
        if (r < I_ABC) { p0_transpose_item(a.in[22], 512, D, (bf16_t*)(ws + WS_WB), 512, nullptr, 0, scr, r, lane); continue; } r -= I_ABC;
        if (r < I_ABC) { p0_transpose_item(a.in[23], 512, D, (bf16_t*)(ws + WS_WC), 512, nullptr, 0, scr, r, lane); continue; } r -= I_ABC;
        p0_transpose_item(a.in[13], 512, 512, (bf16_t*)(ws + WS_WGLU), 512, nullptr, 0, scr, r, lane);
    }
#pragma unroll 1
    for (int r3 = gw; r3 < (T + TM) / 3; r3 += NGW) {
        const int r = 3 * r3;
        if (r + 3 <= T) rms_rows_bf16<3>(a.in[0] + (size_t)r * D, a.in[2], (bf16_t*)(ws + WS_R1) + (size_t)r * D, lane);
        else if (r >= T) rms_rows_bf16<3>(a.in[1] + (size_t)(r - T) * D, a.in[19], (bf16_t*)(ws + WS_MEMN) + (size_t)(r - T) * D, lane);
        else { for (int rr = r; rr < r + 3; ++rr) { if (rr < T) rms_rows_bf16<1>(a.in[0] + (size_t)rr * D, a.in[2], (bf16_t*)(ws + WS_R1) + (size_t)rr * D, lane);
                                                     else rms_rows_bf16<1>(a.in[1] + (size_t)(rr - T) * D, a.in[19], (bf16_t*)(ws + WS_MEMN) + (size_t)(rr - T) * D, lane); } }
    }
    { bf16_t* Wm = (bf16_t*)(ws + WS_WM); const float* w_s = a.in[17];
      for (int e = bx * NTHREADS + tid; e < SGG * SGB * SGB; e += G * NTHREADS) { const int t = (e >> 7) & 127, s = e & 127; Wm[e] = (s <= t) ? f2bf(w_s[e]) : (bf16_t)0; } }
}
__device__ __forceinline__ void s5l_phase(const MArgs& a, LAS unsigned char* lds, int G, int bx, int tid, int wave, int lane) {
    unsigned char* ws = a.ws;
    bf16_t* Ag = (bf16_t*)(ws + WS_R2); const bf16_t* WendT = (const bf16_t*)(ws + WS_WEND); const float* A16 = (const float*)(ws + WS_TABE);
    const int fr = lane & 15, fq = lane >> 4;
    LAS float* L = (LAS float*)lds;
#pragma unroll 1
    for (int task = bx; task < 256; task += G) {
        const int g = task >> 3, b = task & 7;
        const bf16_t* Arow = Ag + ((size_t)g * NCH + b * 128 + wave * 16 + fr) * KE + fq * 8;
        bf16x8 af[8];
#pragma unroll
        for (int ks = 0; ks < 8; ++ks) af[ks] = *(const bf16x8*)(Arow + 32 * ks);
        const bf16_t* Brow = WendT + ((size_t)g * 128 + fr) * 256 + fq * 8;
#pragma unroll
        for (int nt = 0; nt < 8; ++nt) {
            f32x4 acc = (f32x4){0.f, 0.f, 0.f, 0.f};
#pragma unroll
            for (int ks = 0; ks < 8; ++ks) { const bf16x8 bfr = *(const bf16x8*)(Brow + nt * 4096 + ks * 32); acc = __builtin_amdgcn_mfma_f32_16x16x32_bf16(af[ks], bfr, acc, 0, 0, 0); }
#pragma unroll
            for (int r = 0; r < 4; ++r) L[(wave * 16 + 4 * fq + r) * 128 + nt * 16 + fr] = acc[r];
        }
        __syncthreads();
        if (tid < 64) {
            const float ar = A16[(g * 64 + tid) * 2], ai = A16[(g * 64 + tid) * 2 + 1];
            float sr = 0.f, si = 0.f;
            bf16_t* dst = Ag + ((size_t)g * NCH + b * 128) * KE + 256 + tid;
#pragma unroll 8
            for (int m = 0; m < 128; ++m) {
                dst[(size_t)m * KE] = f2bf(sr); dst[(size_t)m * KE + 64] = f2bf(si);
                const float lr = L[m * 128 + tid], li = L[m * 128 + 64 + tid];
                const float nr = ar * sr - ai * si + lr, ni = ar * si + ai * sr + li; sr = nr; si = ni;
            }
        }
        __syncthreads();
    }
}

__device__ __forceinline__ void sgu_phase(const MArgs& a, LAS unsigned char* lds, int G, int bx, int tid, int wave, int lane) {
    unsigned char* ws = a.ws;
    const bf16_t* gu = (const bf16_t*)((unsigned char*)a.out + 16 * MiB); const bf16_t* gv = (const bf16_t*)((unsigned char*)a.out + 32 * MiB); bf16_t* sgu = (bf16_t*)((unsigned char*)a.out + 48 * MiB);
    const bf16_t* Wm = (const bf16_t*)(ws + WS_WM); const float* b_s = a.in[18]; const float* gam = a.in[15]; const float* bet = a.in[16];
    const int fr = lane & 15, fq = lane >> 4;
    LAS float* st = (LAS float*)lds;
    LAS unsigned char* vTl = lds + 1024;
#pragma unroll 1
    for (int unit = bx; unit < T / SGB; unit += G) {
        const int t0 = unit * SGB;
#pragma unroll 1
        for (int i = 0; i < 16; ++i) {
            const int s = wave * 16 + i;
            const u32x4 rv = *(const u32x4*)(gv + (size_t)(t0 + s) * 512 + lane * 8);
            const f32x4 v0 = unpk_lo(rv), v1 = unpk_hi(rv);
            const float mu = wave_sum((v0[0] + v0[1]) + (v0[2] + v0[3]) + (v1[0] + v1[1]) + (v1[2] + v1[3])) * (1.f / 512.f);
            const f32x4 d0 = v0 - mu, d1 = v1 - mu;
            const float var = wave_sum((d0[0] * d0[0] + d0[1] * d0[1]) + (d0[2] * d0[2] + d0[3] * d0[3]) + (d1[0] * d1[0] + d1[1] * d1[1]) + (d1[2] * d1[2] + d1[3] * d1[3])) * (1.f / 512.f);
            if (lane == 0) { st[s * 2] = mu; st[s * 2 + 1] = rsqrtf(var + EPS); }
        }
        __syncthreads();
#pragma unroll 1
        for (int g = 0; g < SGG; ++g) {
#pragma unroll
            for (int i = 0; i < 4; ++i) {
                const int id = i * 512 + tid, s = id & 127, dc = id >> 7, ch = g * 128 + dc * 8;
                const u32x4 rv = *(const u32x4*)(gv + (size_t)(t0 + s) * 512 + ch);
                const float mu = st[s * 2], rs = st[s * 2 + 1];
                const f32x4 g0 = *(const f32x4*)(gam + ch), g1 = *(const f32x4*)(gam + ch + 4), b0 = *(const f32x4*)(bet + ch), b1 = *(const f32x4*)(bet + ch + 4);
                const f32x4 o0 = (unpk_lo(rv) - mu) * rs * g0 + b0, o1 = (unpk_hi(rv) - mu) * rs * g1 + b1;
                LAS bf16_t* dp = (LAS bf16_t*)(vTl + (dc * 8) * 272 + s * 2);
                dp[0 * 136] = f2bf(o0[0]); dp[1 * 136] = f2bf(o0[1]); dp[2 * 136] = f2bf(o0[2]); dp[3 * 136] = f2bf(o0[3]);
                dp[4 * 136] = f2bf(o1[0]); dp[5 * 136] = f2bf(o1[1]); dp[6 * 136] = f2bf(o1[2]); dp[7 * 136] = f2bf(o1[3]);
            }
            __syncthreads();
            f32x4 acc[8];
#pragma unroll
            for (int nt = 0; nt < 8; ++nt) acc[nt] = (f32x4){0.f, 0.f, 0.f, 0.f};
            const int ksmax = (wave * 16 + 15) >> 5;
            const bf16_t* Wrow = Wm + ((size_t)(g * 128 + wave * 16 + fr)) * 128 + fq * 8;
#pragma unroll 1
            for (int ks = 0; ks <= ksmax; ++ks) {
                const bf16x8 wf = *(const bf16x8*)(Wrow + ks * 32);
#pragma unroll
                for (int nt = 0; nt < 8; ++nt) { const bf16x8 vf = *(const LAS bf16x8*)(vTl + (nt * 16 + fr) * 272 + (ks * 32 + fq * 8) * 2); acc[nt] = __builtin_amdgcn_mfma_f32_16x16x32_bf16(vf, wf, acc[nt], 0, 0, 0); }
            }
            const int t = wave * 16 + fr; const float bias = b_s[g * 128 + t];
            const size_t ro = (size_t)(t0 + t) * 512 + g * 128 + 4 * fq;
#pragma unroll
            for (int nt = 0; nt < 8; ++nt) {
                const u32x2 uv = *(const u32x2*)(gu + ro + nt * 16);
                const float u0 = __uint_as_float(uv.x << 16), u1 = __uint_as_float(uv.x & 0xffff0000u), u2 = __uint_as_float(uv.y << 16), u3 = __uint_as_float(uv.y & 0xffff0000u);
                u32x2 w; w.x = cvtpk(u0 * (acc[nt][0] + bias), u1 * (acc[nt][1] + bias)); w.y = cvtpk(u2 * (acc[nt][2] + bias), u3 * (acc[nt][3] + bias));
                *(u32x2*)(sgu + ro + nt * 16) = w;
            }
            __syncthreads();
        }
    }
}

constexpr int AT_KROW = 272, AT_VROW = 528, AT_VOFF = 256 * AT_KROW;
__device__ __forceinline__ void attn_phase(const MArgs& a, LAS unsigned char* lds, int G, int bx, int tid, int wave, int lane) {
    unsigned char* ws = a.ws;
    const bf16_t* q = (const bf16_t*)((unsigned char*)a.out); const bf16_t* kb = (const bf16_t*)(ws + WS_KB); const bf16_t* vT = (const bf16_t*)(ws + WS_VT); bf16_t* ob = (bf16_t*)(ws + WS_R6);
    const int fr = lane & 15, fq = lane >> 4;
    LAS unsigned char* Ks = lds; LAS unsigned char* Vs = lds + AT_VOFF;
#pragma unroll 1
    for (int unit = bx; unit < NB * XH * 8; unit += G) {
        const int b = unit >> 5, hh = (unit >> 3) & 3, qb = unit & 7, t0 = b * SEQ + qb * 256;
#pragma unroll
        for (int i = 0; i < 8; ++i) { const int id = i * 512 + tid, row = id >> 4, ch = id & 15;
            *(LAS u32x4*)(Ks + row * AT_KROW + ch * 16) = *(const u32x4*)(kb + (size_t)(b * 256 + row) * 512 + hh * 128 + ch * 8); }
#pragma unroll
        for (int i = 0; i < 8; ++i) { const int id = i * 512 + tid, row = id >> 5, ch = id & 31;
            *(LAS u32x4*)(Vs + row * AT_VROW + ch * 16) = *(const u32x4*)(vT + ((size_t)(b * 4 + hh) * 128 + row) * 256 + ch * 8); }
        __syncthreads();
#pragma unroll 1
        for (int mt = 0; mt < 2; ++mt) {
            const int trow = t0 + wave * 32 + mt * 16 + fr;
            bf16x8 qf[4];
#pragma unroll
            for (int ks = 0; ks < 4; ++ks) qf[ks] = *(const bf16x8*)(q + (size_t)trow * 512 + hh * 128 + ks * 32 + fq * 8);
            f32x4 s[16];
#pragma unroll
            for (int nt = 0; nt < 16; ++nt) { s[nt] = (f32x4){0.f, 0.f, 0.f, 0.f};
#pragma unroll
                for (int ks = 0; ks < 4; ++ks) { const bf16x8 kf = *(const LAS bf16x8*)(Ks + (nt * 16 + fr) * AT_KROW + (ks * 32 + fq * 8) * 2); s[nt] = __builtin_amdgcn_mfma_f32_16x16x32_bf16(kf, qf[ks], s[nt], 0, 0, 0); }
                if (nt & 1) __builtin_amdgcn_sched_barrier(0); }
            float mx = s[0][0];
#pragma unroll
            for (int nt = 0; nt < 16; ++nt) mx = fmaxf(fmaxf(mx, fmaxf(s[nt][0], s[nt][1])), fmaxf(s[nt][2], s[nt][3]));
            mx = fmaxf(mx, __shfl_xor(mx, 16)); mx = fmaxf(mx, __shfl_xor(mx, 32));
            const float mneg = -mx * 1.4426950408889634f; float l = 0.f;
#pragma unroll
            for (int nt = 0; nt < 16; ++nt)
#pragma unroll
                for (int r = 0; r < 4; ++r) { const float p = __builtin_amdgcn_exp2f(__builtin_fmaf(s[nt][r], 1.4426950408889634f, mneg)); s[nt][r] = p; l += p; }
            l += __shfl_xor(l, 16); l += __shfl_xor(l, 32);
            bf16x8 pf[8];
#pragma unroll
            for (int k2 = 0; k2 < 8; ++k2) { const u32x4 w = pack8(s[2 * k2], s[2 * k2 + 1]); pf[k2] = __builtin_bit_cast(bf16x8, w); }
            const float rl = 1.f / l;
            bf16_t* orow = ob + (size_t)trow * 512 + hh * 128 + 4 * fq;
#pragma unroll
            for (int dt = 0; dt < 8; ++dt) {
                f32x4 o = (f32x4){0.f, 0.f, 0.f, 0.f};
#pragma unroll
                for (int k2 = 0; k2 < 8; ++k2) {
                    const LAS unsigned char* vp = Vs + (dt * 16 + fr) * AT_VROW + (k2 * 32 + fq * 4) * 2;
                    const u32x2 lo = *(const LAS u32x2*)vp, hi = *(const LAS u32x2*)(vp + 32);
                    const u32x4 vv = (u32x4){lo.x, lo.y, hi.x, hi.y};
                    o = __builtin_amdgcn_mfma_f32_16x16x32_bf16(__builtin_bit_cast(bf16x8, vv), pf[k2], o, 0, 0, 0);
                }
                u32x2 w; w.x = cvtpk(o[0] * rl, o[1] * rl); w.y = cvtpk(o[2] * rl, o[3] * rl);
                *(u32x2*)(orow + dt * 16) = w;
                __builtin_amdgcn_sched_barrier(0);
            }
        }
        __syncthreads();
    }
}

#ifndef PH_EN
#define PH_EN W_ALL
#endif
__global__ void __launch_bounds__(NTHREADS, 2) mega_fwd(MArgs a) {
    extern __shared__ __attribute__((aligned(16))) unsigned char lds_raw[];
    LAS unsigned char* lds = (LAS unsigned char*)lds_raw;
    const int tid = threadIdx.x, lane = tid & 63, wave = __builtin_amdgcn_readfirstlane(tid >> 6);
    const int G = gridDim.x, bx = blockIdx.x, mask = a.mask;
    unsigned char* ws = a.ws;
    for (int u = tid; u < (LDS_BYTES - LDSCTL_OFF) / 4; u += NTHREADS) ((LAS unsigned*)(lds + LDSCTL_OFF))[u] = 0u;
    __syncthreads();
    XcdBarrier bar; bar.bar = (unsigned*)(ws + WS_CTL) + CW_BAR; bar.x = 0; bar.st = nullptr;
    if (a.bars) bar = xcd_barrier_post((unsigned*)(ws + WS_CTL) + CW_BAR, (volatile LAS unsigned*)(lds + LDSCTL_OFF) + 8);
#define GRID_BAR(k) do { if (a.bars & (1 << (k))) xcd_barrier(bar); } while (0)
#define P_BF(off) ((bf16_t*)(ws + (off)))
#define WinT P_BF(WS_WIN)
#define WguT P_BF(WS_WGU)
#define WdT P_BF(WS_WD)
#define WkvT P_BF(WS_WKV)
#define WoutT P_BF(WS_WOUT)
#define WaT P_BF(WS_WA)
#define WbT P_BF(WS_WB)
#define WcT P_BF(WS_WC)
#define WgluT P_BF(WS_WGLU)
#define KmatT P_BF(WS_KMAT)
#define memn P_BF(WS_MEMN)
#define kb P_BF(WS_KB)
#define vT P_BF(WS_VT)
#define h P_BF(WS_R1)
#define yap P_BF(WS_R1)
#define merged P_BF(WS_R1)
#define Ag P_BF(WS_R2)
#define yag P_BF(WS_R2)
#define x1b P_BF(WS_R2)
#define ob P_BF(WS_R6)
#define gates P_BF(WS_R7)
#define act P_BF(WS_R7)
#define q ((bf16_t*)((unsigned char*)a.out))
#define gu ((bf16_t*)((unsigned char*)a.out + 16 * MiB))
#define gv ((bf16_t*)((unsigned char*)a.out + 32 * MiB))
#define sgu ((bf16_t*)((unsigned char*)a.out + 48 * MiB))
#define ss1 ((float*)(ws + WS_CTL + CTL_SS1))
#define ss2 ((float*)(ws + WS_CTL + CTL_SS2))
    if ((PH_EN & W_PREP) && (mask & W_PREP)) prep_phase(a, lds, G, bx, tid, wave, lane);
    GRID_BAR(0);
    if ((PH_EN & W_INPROJ) && (mask & W_INPROJ)) { TileOrder S; S.init(T, INW, G, bx, h, D, WinT, D); EpiInprojM E{Ag, gu, gv, q, gates, a.in[4]}; gemm_phase(lds, D, D, D / BK, S, E); }
    GRID_BAR(1);
    if ((PH_EN & W_S5L) && (mask & W_S5L)) s5l_phase(a, lds, G, bx, tid, wave, lane);
    if ((PH_EN & W_KV) && (mask & W_KV)) { KvOrder S{G, bx, (const char*)memn, (const char*)WkvT}; EpiKVM E{kb, vT}; gemm_phase(lds, D, D, D / BK, S, E); }
    if ((PH_EN & W_SGU) && (mask & W_SGU)) sgu_phase(a, lds, G, bx, tid, wave, lane);
    GRID_BAR(2);
    if ((PH_EN & W_S5Y) && (mask & W_S5Y)) { S5YOrder S{G, bx, (const char*)Ag, (const char*)KmatT}; EpiS5YM E{yap}; gemm_phase(lds, KE, KE, KE / BK, S, E); }
    if ((PH_EN & W_ATTN) && (mask & W_ATTN)) attn_phase(a, lds, G, bx, tid, wave, lane);
    GRID_BAR(3);
    if ((PH_EN & W_GLU) && (mask & W_GLU)) { TileOrder S; S.init(T, 512, G, bx, yap, 512, WgluT, 512); EpiGluM E{yap, a.in[14], yag}; gemm_phase(lds, 512, 512, 512 / BK, S, E); }
    GRID_BAR(4);
    if ((PH_EN & W_MERGE) && (mask & W_MERGE)) { MergeOrder S; S.T.init(T, D, G, bx, nullptr, 512, nullptr, 512); S.a0 = (const char*)yag; S.da1 = (const char*)sgu - (const char*)yag; S.da2 = (const char*)ob - (const char*)yag;
        S.b0 = (const char*)WaT; S.db1 = (const char*)WbT - (const char*)WaT; S.db2 = (const char*)WcT - (const char*)WaT; S.ta = (size_t)BM * 512 * 2; S.tb = (size_t)BM * 512 * 2;
        EpiMergeM E{gates, merged}; gemm_phase(lds, 512, 512, 512 / BK, S, E); }
    GRID_BAR(5);
    if ((PH_EN & W_WOUT) && (mask & W_WOUT)) { TileOrder S; S.init(T, D, G, bx, merged, D, WoutT, D); EpiResM E{a.in[0], a.out, x1b, ss1}; gemm_phase(lds, D, D, D / BK, S, E); }
    GRID_BAR(6);
    if ((PH_EN & W_FFNUP) && (mask & W_FFNUP)) { TileOrder S; S.init(T, NGU, G, bx, x1b, D, WguT, D); EpiFfnUpM E{ss1, act}; gemm_phase(lds, D, D, D / BK, S, E); }
    GRID_BAR(7);
    if ((PH_EN & W_FFNDOWN) && (mask & W_FFNDOWN)) { TileOrder S; S.init(T, D, G, bx, act, DFF, WdT, DFF); EpiResM E{a.out, a.out, nullptr, ss2}; gemm_phase(lds, DFF, DFF, DFF / BK, S, E); }
    if (mask & 8192) { TileOrder S; S.init(T, D, G, bx, act, DFF, WdT, DFF); EpiResM E{a.out, (float*)(ws + WS_R1), nullptr, ss1}; gemm_phase(lds, DFF, DFF, DFF / BK, S, E); }
    GRID_BAR(8);
    if (mask & 16384) {
        const int gw = bx * NWAVES + wave, NGW = G * NWAVES; const float* gf = a.in[29];
        for (int r = gw; r < T; r += NGW) { f32x4* xr = (f32x4*)(a.out + (size_t)r * D) + lane; f32x4* xo = (f32x4*)((float*)(ws + WS_R1) + (size_t)r * D) + lane; const float rs = rsqrtf(ss2[r] * (1.f / D) + EPS);
#pragma unroll
            for (int j = 0; j < 4; ++j) { const f32x4 gg = ((const f32x4*)gf)[64 * j + lane]; xo[64 * j] = xr[64 * j] * rs * gg; } }
    }
    if ((PH_EN & W_FINAL) && (mask & W_FINAL)) {
        const int gw = bx * NWAVES + wave, NGW = G * NWAVES; const float* gf = a.in[29];
        for (int r = gw; r < T; r += NGW) { f32x4* xr = (f32x4*)(a.out + (size_t)r * D) + lane; const float rs = rsqrtf(ss2[r] * (1.f / D) + EPS);
#pragma unroll
            for (int j = 0; j < 4; ++j) { const f32x4 gg = ((const f32x4*)gf)[64 * j + lane]; xr[64 * j] = xr[64 * j] * rs * gg; } }
    }
#undef GRID_BAR
#undef WinT
#undef WguT
#undef WdT
#undef WkvT
#undef WoutT
#undef WaT
#undef WbT
#undef WcT
#undef WgluT
#undef KmatT
#undef memn
#undef kb
#undef vT
#undef h
#undef yap
#undef merged
#undef Ag
#undef yag
#undef x1b
#undef ob
#undef gates
#undef act
#undef q
#undef gu
#undef gv
#undef sgu
#undef ss1
#undef ss2
}

#ifndef MEGA_STAGES
#define MEGA_STAGES 0
#endif
#ifndef ONE_LAUNCH
#define ONE_LAUNCH 0
#endif
extern "C" void kernel_launch(void* const* d_in, const int* in_sizes, int n_in, void* d_out, int out_size, void* d_ws, size_t ws_size, hipStream_t stream) {
    static int grid = 0;
    if (grid == 0) {
        if (n_in != 30 || out_size != T * D || ws_size < WS_END) { fprintf(stderr, "kernel_launch: unexpected sizes n_in %d out %d ws %zu\n", n_in, out_size, ws_size); grid = -1; return; }
        int dev = 0, cus = 0, per_cu = 0;
        if (hipGetDevice(&dev) != hipSuccess || hipDeviceGetAttribute(&cus, hipDeviceAttributeMultiprocessorCount, dev) != hipSuccess) { grid = -1; return; }
        if (hipFuncSetAttribute((const void*)mega_fwd, hipFuncAttributeMaxDynamicSharedMemorySize, LDS_BYTES) != hipSuccess) { fprintf(stderr, "kernel_launch: hipFuncSetAttribute failed\n"); grid = -1; return; }
        if (hipOccupancyMaxActiveBlocksPerMultiprocessor(&per_cu, (const void*)mega_fwd, NTHREADS, LDS_BYTES) != hipSuccess || per_cu < 1) { fprintf(stderr, "kernel_launch: occupancy query says %d blocks/CU\n", per_cu); (void)hipGetLastError(); }
        grid = cus;
    }
    if (grid < 0) return;
    const float* x = (const float*)d_in[0]; const float* mem = (const float*)d_in[1]; const float* g_mix = (const float*)d_in[2]; const float* w_in = (const float*)d_in[3];
    const float* b_gate = (const float*)d_in[4]; const float* a_re = (const float*)d_in[5]; const float* a_im = (const float*)d_in[6]; const float* log_dt = (const float*)d_in[7];
    const float* bm_re = (const float*)d_in[8]; const float* bm_im = (const float*)d_in[9]; const float* cm_re = (const float*)d_in[10]; const float* cm_im = (const float*)d_in[11];
    const float* d_skip = (const float*)d_in[12]; const float* w_glu = (const float*)d_in[13]; const float* b_glu = (const float*)d_in[14]; const float* g_sgu = (const float*)d_in[15];
    const float* beta_sgu = (const float*)d_in[16]; const float* w_s = (const float*)d_in[17]; const float* b_s = (const float*)d_in[18]; const float* g_mem = (const float*)d_in[19];
    const float* w_kv = (const float*)d_in[20]; const float* w_a = (const float*)d_in[21]; const float* w_b = (const float*)d_in[22]; const float* w_c = (const float*)d_in[23];
    const float* w_out = (const float*)d_in[24]; const float* g_ffn = (const float*)d_in[25]; const float* w_gate = (const float*)d_in[26]; const float* w_up = (const float*)d_in[27];
    const float* w_down = (const float*)d_in[28]; const float* g_final = (const float*)d_in[29];
    unsigned char* ws = (unsigned char*)d_ws; float* out = (float*)d_out;
    bf16_t* WinT = (bf16_t*)(ws + WS_WIN); bf16_t* WguT = (bf16_t*)(ws + WS_WGU); bf16_t* WdT = (bf16_t*)(ws + WS_WD); bf16_t* WkvT = (bf16_t*)(ws + WS_WKV); bf16_t* WoutT = (bf16_t*)(ws + WS_WOUT);
    bf16_t* WaT = (bf16_t*)(ws + WS_WA); bf16_t* WbT = (bf16_t*)(ws + WS_WB); bf16_t* WcT = (bf16_t*)(ws + WS_WC); bf16_t* WgluT = (bf16_t*)(ws + WS_WGLU);
    bf16_t* KmatT = (bf16_t*)(ws + WS_KMAT); bf16_t* WendT = (bf16_t*)(ws + WS_WEND); bf16_t* Wm = (bf16_t*)(ws + WS_WM); float* tabE = (float*)(ws + WS_TABE); float* tabB = (float*)(ws + WS_TABB);
    float* sgst = (float*)(ws + WS_SGST); bf16_t* memn = (bf16_t*)(ws + WS_MEMN); bf16_t* kb = (bf16_t*)(ws + WS_KB); bf16_t* vT = (bf16_t*)(ws + WS_VT);
    bf16_t* h = (bf16_t*)(ws + WS_R1); bf16_t* yap = (bf16_t*)(ws + WS_R1); bf16_t* merged = (bf16_t*)(ws + WS_R1);
    bf16_t* Ag = (bf16_t*)(ws + WS_R2); bf16_t* yag = (bf16_t*)(ws + WS_R2); bf16_t* x1b = (bf16_t*)(ws + WS_R2); bf16_t* ob = (bf16_t*)(ws + WS_R6);
    bf16_t* gates = (bf16_t*)(ws + WS_R7); bf16_t* act = (bf16_t*)(ws + WS_R7);
    bf16_t* q = (bf16_t*)((unsigned char*)d_out); bf16_t* gu = (bf16_t*)((unsigned char*)d_out + 16 * MiB); bf16_t* gv = (bf16_t*)((unsigned char*)d_out + 32 * MiB); bf16_t* sgu = (bf16_t*)((unsigned char*)d_out + 48 * MiB);
    float* ss1 = (float*)(ws + WS_CTL + CTL_SS1); float* ss2 = (float*)(ws + WS_CTL + CTL_SS2);
    (void)tabE; (void)tabB; (void)KmatT; (void)WendT;

    MArgs ma{};
    for (int i = 0; i < 30; ++i) ma.in[i] = (const float*)d_in[i];
    ma.out = out; ma.ws = ws;
    (void)hipMemsetAsync(ws + WS_CTL, 0, 1 * MiB, stream);
#define MEGA(m, b) do { ma.mask = (m); ma.bars = (b); hipLaunchKernelGGL(mega_fwd, dim3(grid), dim3(NTHREADS), LDS_BYTES, stream, ma); } while (0)
#define ISM(w) ((MEGA_STAGES) & (w))
#ifndef DUP_MASK
#define DUP_MASK 0
#endif
#define DUPM(w) do { if ((DUP_MASK) & (w)) { if ((w) == W_WOUT) (void)hipMemsetAsync(ws + WS_CTL + CTL_SS1, 0, 65536, stream); MEGA(w, 0); } } while (0)
    if (ONE_LAUNCH) { MEGA(W_ALL, 0x1ff); return; }
    if (ISM(W_PREP)) { MEGA(W_PREP, 0); DUPM(W_PREP); }
    else {
        k_tconv<<<dim3(INW / 64, D / 64), 512, 0, stream>>>(w_in, D, INW, WinT, D, nullptr, 0, 0);
        k_tconv<<<dim3(DFF / 64, D / 64), 512, 0, stream>>>(w_gate, D, DFF, WguT, D, g_ffn, 1, 0);
        k_tconv<<<dim3(DFF / 64, D / 64), 512, 0, stream>>>(w_up, D, DFF, WguT, D, g_ffn, 2, 0);
        k_tconv<<<dim3(D / 64, DFF / 64), 512, 0, stream>>>(w_down, DFF, D, WdT, DFF, nullptr, 0, 0);
        k_tconv<<<dim3(1024 / 64, D / 64), 512, 0, stream>>>(w_kv, D, 1024, WkvT, D, nullptr, 0, 0);
        k_tconv<<<dim3(D / 64, D / 64), 512, 0, stream>>>(w_out, D, D, WoutT, D, nullptr, 0, 0);
        k_tconv<<<dim3(D / 64, 512 / 64), 512, 0, stream>>>(w_a, 512, D, WaT, 512, nullptr, 0, 0);
        k_tconv<<<dim3(D / 64, 512 / 64), 512, 0, stream>>>(w_b, 512, D, WbT, 512, nullptr, 0, 0);
        k_tconv<<<dim3(D / 64, 512 / 64), 512, 0, stream>>>(w_c, 512, D, WcT, 512, nullptr, 0, 0);
        k_tconv<<<dim3(512 / 64, 512 / 64), 512, 0, stream>>>(w_glu, 512, 512, WgluT, 512, nullptr, 0, 0);
        k_rmsrows<<<T / 8, 512, 0, stream>>>(x, g_mix, h, T);
        k_rmsrows<<<TM / 8, 512, 0, stream>>>(mem, g_mem, memn, TM);
        k_s5tab<<<(S5G * S5P + 255) / 256, 256, 0, stream>>>(a_re, a_im, log_dt, bm_re, bm_im, tabE, tabB);
        k_s5mats<<<dim3((256 * KE + 128 * 256) / 256, S5G), 256, 0, stream>>>(tabE, tabB, cm_re, cm_im, d_skip, KmatT, WendT);
        k_wm<<<(SGG * SGB * SGB + 255) / 256, 256, 0, stream>>>(w_s, Wm);
    }
    if (ISM(W_INPROJ)) { MEGA(W_INPROJ, 0); DUPM(W_INPROJ); } else k_ngemm<EpiInproj><<<dim3(INW / 64, T / 4), 256, 0, stream>>>(h, D, WinT, D, D, EpiInproj{Ag, gu, gv, q, gates, b_gate});
    if (ISM(W_KV)) { MEGA(W_KV, 0); DUPM(W_KV); } else k_ngemm<EpiKV><<<dim3(1024 / 64, TM / 4), 256, 0, stream>>>(memn, D, WkvT, D, D, EpiKV{kb, vT});
    if (ISM(W_S5L)) { MEGA(W_S5L, 0); DUPM(W_S5L); MEGA(W_S5Y, 0); DUPM(W_S5Y); } else k_s5_naive<<<NB * S5G, 64, 0, stream>>>(Ag, a_re, a_im, log_dt, bm_re, bm_im, cm_re, cm_im, d_skip, yap);
    if (ISM(W_ATTN)) { MEGA(W_ATTN, 0); DUPM(W_ATTN); } else k_attn_naive<<<T * XH, 256, 0, stream>>>(q, kb, vT, ob);
    if (ISM(W_SGU)) { MEGA(W_SGU, 0); DUPM(W_SGU); }
    else { k_sgu_stats<<<T / 8, 512, 0, stream>>>(gv, sgst); k_sgu_naive<<<dim3(2, T), 256, 0, stream>>>(gu, gv, sgst, Wm, b_s, g_sgu, beta_sgu, sgu); }
    if (ISM(W_GLU)) { MEGA(W_GLU, 0); DUPM(W_GLU); } else k_ngemm<EpiGlu><<<dim3(512 / 64, T / 4), 256, 0, stream>>>(yap, 512, WgluT, 512, 512, EpiGlu{yap, b_glu, yag});
    if (ISM(W_MERGE)) { MEGA(W_MERGE, 0); DUPM(W_MERGE); } else k_merge_naive<<<dim3(D / 64, T / 4), 256, 0, stream>>>(yag, sgu, ob, WaT, WbT, WcT, gates, merged);
    if (ISM(W_WOUT)) { MEGA(W_WOUT, 0); DUPM(W_WOUT); }
    else { k_ngemm<EpiWout><<<dim3(D / 64, T / 4), 256, 0, stream>>>(merged, D, WoutT, D, D, EpiWout{x, out, x1b}); k_rowss<<<T / 8, 512, 0, stream>>>(out, ss1); }
    if (ISM(W_FFNUP)) { MEGA(W_FFNUP, 0); DUPM(W_FFNUP); } else k_ffnup_naive<<<dim3(DFF / 64, T / 4), 256, 0, stream>>>(x1b, WguT, ss1, act);
    if ((DUP_MASK) & 8192) MEGA(8192, 0);
    if (ISM(W_FFNDOWN)) MEGA(W_FFNDOWN, 0);
    else { k_ngemm<EpiDown><<<dim3(D / 64, T / 4), 256, 0, stream>>>(act, DFF, WdT, DFF, DFF, EpiDown{out}); k_rowss<<<T / 8, 512, 0, stream>>>(out, ss2); }
    if ((DUP_MASK) & 16384) MEGA(16384, 0);
    if (ISM(W_FINAL)) { MEGA(W_FINAL, 0); } else k_final<<<T * D / 4 / 256, 256, 0, stream>>>(out, ss2, g_final);
}
```
